# Optimizing an MI355X kernel written in HIP

```python
import jax
import jax.numpy as jnp
from jax import lax
import numpy as np

D_MODEL = 1024
BATCH = 8
SEQ = 2048
DEPTH = 2
DEC_BATCH = 32
DEC_SEQ = 4
PAST_LEN = 16384
PAGE_SIZE = 128

HEAD_DIM = 64
N_GROUP_HEADS = 4
GROUP_WIDTH = N_GROUP_HEADS * HEAD_DIM
D_MIX = 4 * GROUP_WIDTH
D_FF = 2816
N_FFN = 2
N_NORMS = 6
EPS = 1e-6

GLA_DK = HEAD_DIM // 2
GLA_DV = HEAD_DIM
GLA_RANK = 16
GLA_TAU = 16.0
GLA_CHUNK = 64

GMLP_CHUNK = 128
LN_EPS = 1e-5

RWKV_N = HEAD_DIM
RWKV_W_RANK = 64
RWKV_A_RANK = 64
RWKV_G_RANK = 128
RWKV_LNX_EPS = 64e-5

DIL_PAIRS = ((128, 1), (512, 4), (2048, 16))
DIL_N_GROUPS = len(DIL_PAIRS)
N_DIL_HEADS = DIL_N_GROUPS * N_GROUP_HEADS
DIL_QBLOCK = 128
ALIBI_MAX_EXP = 8.0

GLA_COLS = 2 * N_GROUP_HEADS * GLA_DK + GROUP_WIDTH + GLA_RANK + GROUP_WIDTH
GMLP_COLS = 2 * GROUP_WIDTH
RWKV_COLS = 3 * GROUP_WIDTH + RWKV_W_RANK + RWKV_A_RANK + RWKV_G_RANK
DIL_COLS = DIL_N_GROUPS * 3 * GROUP_WIDTH
N_IN_COLS = GLA_COLS + GMLP_COLS + RWKV_COLS + DIL_COLS

kernel_name = 'hybrid_parallel_groups_decode_step'


def rms_norm(x, g):
    xf = x.astype(jnp.float32)
    y = xf * lax.rsqrt(jnp.mean(xf * xf, axis=-1, keepdims=True) + EPS)
    return (y * g.astype(jnp.float32)).astype(x.dtype)


def swiglu(x, wg, wu, wd):
    return (jax.nn.silu(x @ wg) * (x @ wu)) @ wd


def split_at(x, sizes):
    return jnp.split(x, np.cumsum(sizes)[:-1].tolist(), axis=-1)


def gla_mix(cols, w_alpha2, b_alpha, norm_g, h0):
    B, T, _ = cols.shape
    H = N_GROUP_HEADS
    f32 = jnp.float32
    q, k, v, a_lr, g = split_at(cols.astype(f32), [H * GLA_DK, H * GLA_DK, GROUP_WIDTH, GLA_RANK, GROUP_WIDTH])
    q = q.reshape(B, T, H, GLA_DK) * GLA_DK ** -0.5
    k = k.reshape(B, T, H, GLA_DK)
    v = v.reshape(B, T, H, GLA_DV)
    log_a = (jax.nn.log_sigmoid(a_lr @ w_alpha2.astype(f32) + b_alpha.astype(f32)) / GLA_TAU).reshape(B, T, H, GLA_DK)
    C = min(GLA_CHUNK, T)
    pad = (-T) % C
    n = (T + pad) // C

    def to_chunks(z):
        return jnp.pad(z, ((0, 0), (0, pad), (0, 0), (0, 0))).reshape(B, n, C, H, z.shape[-1])

    q, k, v, log_a = (to_chunks(z) for z in (q, k, v, log_a))
    b = jnp.cumsum(log_a, axis=2)
    b_last = b[:, :, -1:]
    qe = q * jnp.exp(b)
    ke = k * jnp.exp(-b)
    kd = k * jnp.exp(b_last - b)
    causal = jnp.tril(jnp.ones((C, C), dtype=bool))
    att = jnp.where(causal, jnp.einsum('bnthk,bnshk->bnhts', qe, ke), 0.0)
    o_intra = jnp.einsum('bnhts,bnshv->bnthv', att, v)
    incr = jnp.einsum('bnshk,bnshv->bnhkv', kd, v)
    decay = jnp.exp(b_last[:, :, 0])

    def step(S, xs):
        dec, inc = xs
        return dec[..., None] * S + inc, S

    s_final, s_in = lax.scan(step, h0.astype(f32), (jnp.moveaxis(decay, 1, 0), jnp.moveaxis(incr, 1, 0)))
    s_in = jnp.moveaxis(s_in, 0, 1)
    o = o_intra + jnp.einsum('bnthk,bnhkv->bnthv', qe, s_in)
    o = o.reshape(B, n * C, H, GLA_DV)[:, :T]
    o = o * lax.rsqrt(jnp.mean(o * o, axis=-1, keepdims=True) + EPS)
    o = o.reshape(B, T, GROUP_WIDTH) * norm_g.astype(f32) * jax.nn.silu(g)
    return o.astype(cols.dtype), s_final


def gmlp_mix(cols, ln_g, ln_b, w_s, b_s):
    B, T, _ = cols.shape
    f32 = jnp.float32
    u, v = jnp.split(jax.nn.gelu(cols.astype(f32), approximate=False), 2, axis=-1)
    mean = jnp.mean(v, axis=-1, keepdims=True)
    var = jnp.mean(jnp.square(v - mean), axis=-1, keepdims=True)
    v = (v - mean) * lax.rsqrt(var + LN_EPS) * ln_g.astype(f32) + ln_b.astype(f32)
    pad = (-T) % GMLP_CHUNK
    n = (T + pad) // GMLP_CHUNK
    vc = jnp.pad(v, ((0, 0), (0, pad), (0, 0))).reshape(B, n, GMLP_CHUNK, N_GROUP_HEADS, HEAD_DIM)
    causal = jnp.tril(jnp.ones((GMLP_CHUNK, GMLP_CHUNK), dtype=bool))
    w = jnp.where(causal, w_s.astype(f32), 0.0)
    s = jnp.einsum('gts,bnsgc->bntgc', w, vc) + b_s.astype(f32).T[None, None, :, :, None]
    s = s.reshape(B, n * GMLP_CHUNK, GROUP_WIDTH)[:, :T]
    return (u * s).astype(cols.dtype), v.astype(cols.dtype)


def rwkv_mix(cols, shift_prev, s0, mu, w0, w2, a0, a2, g2, k_k, k_a, r_k, lnx_g, lnx_b):
    B, T, _ = cols.shape
    H, N = N_GROUP_HEADS, RWKV_N
    f32 = jnp.float32
    c = cols.astype(f32)
    prev = jnp.concatenate([shift_prev.astype(f32)[:, None], c[:, :-1]], axis=1)
    xm = c + (prev - c) * mu.astype(f32)
    r, k, v, w_lr, a_lr, g_lr = split_at(xm, [GROUP_WIDTH] * 3 + [RWKV_W_RANK, RWKV_A_RANK, RWKV_G_RANK])
    w = -jax.nn.softplus(-(w0.astype(f32) + jnp.tanh(w_lr) @ w2.astype(f32))) - 0.5
    decay = jnp.exp(-jnp.exp(w))
    a = jax.nn.sigmoid(a0.astype(f32) + a_lr @ a2.astype(f32))
    g = jax.nn.sigmoid(g_lr) @ g2.astype(f32)

    def heads(z):
        return z.reshape(B, T, H, N)

    kk = heads(k * k_k.astype(f32))
    kk = kk / jnp.maximum(jnp.linalg.norm(kk, axis=-1, keepdims=True), 1e-12)
    k = k * (1.0 + (a - 1.0) * k_a.astype(f32))
    r, k, v, decay, a = heads(r), heads(k), heads(v), heads(decay), heads(a)

    def step(S, xs):
        r_t, w_t, k_t, v_t, a_t, b_t = xs
        sa = jnp.einsum('bhvk,bhk->bhv', S, a_t)
        S = S * w_t[:, :, None, :] + sa[..., None] * b_t[:, :, None, :] + v_t[..., None] * k_t[:, :, None, :]
        return S, jnp.einsum('bhvk,bhk->bhv', S, r_t)

    def tm(z):
        return jnp.moveaxis(z, 1, 0)

    s_final, y = lax.scan(step, s0.astype(f32), (tm(r), tm(decay), tm(k), tm(v), tm(-kk), tm(kk * a)))
    y = jnp.moveaxis(y, 0, 1)
    mean = jnp.mean(y, axis=-1, keepdims=True)
    var = jnp.mean(jnp.square(y - mean), axis=-1, keepdims=True)
    y = ((y - mean) * lax.rsqrt(var + RWKV_LNX_EPS)).reshape(B, T, GROUP_WIDTH) * lnx_g.astype(f32) + lnx_b.astype(f32)
    bonus = jnp.sum(r * k * r_k.astype(f32).reshape(H, N), axis=-1, keepdims=True) * v
    o = (y + bonus.reshape(B, T, GROUP_WIDTH)) * g
    return o.astype(cols.dtype), s_final, cols[:, -1]


def dilated_group(q, kv_new, past, window, dilation, slopes):
    B, T, H, dh = q.shape
    L = past.shape[1]
    f32 = jnp.float32
    J = window // dilation + 1
    ext = jnp.concatenate([jnp.zeros((B, window - L, 2, H, dh), kv_new.dtype), past.astype(kv_new.dtype), kv_new], axis=1)
    qb = T if T <= DIL_QBLOCK else DIL_QBLOCK
    nb = T // qb
    offs = jnp.arange(J) * dilation
    bias = -slopes[:, None] * offs[None, :].astype(f32)

    def block(args):
        nblk, qblk = args
        i = nblk * qb + jnp.arange(qb)
        idx = window + i[:, None] - offs[None, :]
        kvg = jnp.take(ext, idx, axis=1)
        valid = (i[:, None] - offs[None, :]) >= -L
        s = jnp.einsum('bqhd,bqjhd->bhqj', qblk, kvg[:, :, :, 0]).astype(f32) + bias[None, :, None, :]
        s = jnp.where(valid[None, None], s, -jnp.inf)
        m = jnp.max(s, axis=-1, keepdims=True)
        p = jnp.exp(s - m)
        den = jnp.sum(p, axis=-1)
        o = jnp.einsum('bhqj,bqjhd->bqhd', p, kvg[:, :, :, 1].astype(f32)) / jnp.transpose(den, (0, 2, 1))[..., None]
        lse = jnp.transpose(m[..., 0] + jnp.log(den), (0, 2, 1))
        return o, lse

    qs = jnp.swapaxes(q.reshape(B, nb, qb, H, dh), 0, 1)
    o, lse = lax.map(block, (jnp.arange(nb), qs))
    o = jnp.swapaxes(o, 0, 1).reshape(B, T, H, dh)
    lse = jnp.swapaxes(lse, 0, 1).reshape(B, T, H)
    return o, lse


def dilated_mix(cols, pasts):
    B, T, _ = cols.shape
    qkv = cols.reshape(B, T, DIL_N_GROUPS, 3, N_GROUP_HEADS, HEAD_DIM)
    slopes = jnp.exp2(-ALIBI_MAX_EXP * (jnp.arange(N_DIL_HEADS, dtype=jnp.float32) + 1.0) / N_DIL_HEADS)
    slopes = slopes.reshape(DIL_N_GROUPS, N_GROUP_HEADS)
    outs, lses, new_kv = [], [], []
    for gi, (window, dilation) in enumerate(DIL_PAIRS):
        q = qkv[:, :, gi, 0] * HEAD_DIM ** -0.5
        kv = qkv[:, :, gi, 1:]
        o, lse = dilated_group(q, kv, pasts[gi], window, dilation, slopes[gi])
        outs.append(o)
        lses.append(lse)
        new_kv.append(kv[:, -min(window, T):])
    wts = jax.nn.softmax(jnp.stack(lses, axis=0), axis=0)
    o = jnp.sum(wts[..., None] * jnp.stack(outs, axis=0), axis=0)
    return o.reshape(B, T, GROUP_WIDTH).astype(cols.dtype), new_kv


def trunk_layer(x, p, gla_h0, rwkv_s0, shift0, pasts):
    ng = p['norms']
    h = x + 0.5 * rms_norm(swiglu(rms_norm(x, ng[0]), p['ff_gate'][0], p['ff_up'][0], p['ff_down'][0]), ng[1])
    cols = rms_norm(h, ng[2]) @ p['w_in']
    c_gla, c_gmlp, c_rwkv, c_dil = split_at(cols, [GLA_COLS, GMLP_COLS, RWKV_COLS, DIL_COLS])
    o_gla, gla_s = gla_mix(c_gla, p['gla_w_alpha2'], p['gla_b_alpha'], p['gla_norm'], gla_h0)
    o_gmlp, gmlp_v = gmlp_mix(c_gmlp, p['gmlp_ln_g'], p['gmlp_ln_b'], p['gmlp_ws'], p['gmlp_bs'])
    o_rwkv, rwkv_s, shift = rwkv_mix(c_rwkv, shift0, rwkv_s0, p['rwkv_mu'], p['rwkv_w0'], p['rwkv_w2'],
                                     p['rwkv_a0'], p['rwkv_a2'], p['rwkv_g2'], p['rwkv_kk'], p['rwkv_ka'],
                                     p['rwkv_rk'], p['rwkv_lnx_g'], p['rwkv_lnx_b'])
    o_dil, kv_new = dilated_mix(c_dil, pasts)
    mix = jnp.concatenate([o_gla, o_gmlp, o_rwkv, o_dil], axis=-1) @ p['w_out']
    h = h + rms_norm(mix, ng[3])
    h = h + 0.5 * rms_norm(swiglu(rms_norm(h, ng[4]), p['ff_gate'][1], p['ff_up'][1], p['ff_down'][1]), ng[5])
    return h, gla_s, rwkv_s, shift, gmlp_v, kv_new


def setup_inputs(seed: int = 0) -> dict:
    key = jax.random.key(seed)
    ks = iter(jax.random.split(key, 48))
    f32 = jnp.float32

    def nrm(shape, scale):
        return jax.random.normal(next(ks), shape, f32) * scale

    def unif(shape, lo, hi):
        return jax.random.uniform(next(ks), shape, f32, minval=lo, maxval=hi)

    inp = {}
    inp['x_prompt'] = nrm((BATCH, SEQ, D_MODEL), 1.0)
    inp['x_sample'] = nrm((DEC_BATCH, DEC_SEQ, D_MODEL), 1.0)
    for window, _ in DIL_PAIRS:
        inp['cache_win%d' % window] = nrm((DEPTH, DEC_BATCH, min(window, PAST_LEN), 2, N_GROUP_HEADS, HEAD_DIM), 1.0)
    inp['state_gla'] = nrm((DEPTH, DEC_BATCH, N_GROUP_HEADS, GLA_DK, GLA_DV), 1.0)
    inp['state_rwkv'] = nrm((DEPTH, DEC_BATCH, N_GROUP_HEADS, RWKV_N, RWKV_N), 0.5)
    inp['state_shift'] = nrm((DEPTH, DEC_BATCH, RWKV_COLS), 1.0)
    inp['norm_gains'] = 1.0 + nrm((DEPTH, N_NORMS, D_MODEL), 0.05)
    inp['w_ff_gate'] = nrm((DEPTH, N_FFN, D_MODEL, D_FF), D_MODEL ** -0.5)
    inp['w_ff_up'] = nrm((DEPTH, N_FFN, D_MODEL, D_FF), D_MODEL ** -0.5)
    inp['w_ff_down'] = nrm((DEPTH, N_FFN, D_FF, D_MODEL), D_FF ** -0.5)
    inp['w_in'] = nrm((DEPTH, D_MODEL, N_IN_COLS), D_MODEL ** -0.5)
    inp['w_out'] = nrm((DEPTH, D_MIX, D_MODEL), D_MIX ** -0.5)
    inp['gla_w_alpha2'] = nrm((DEPTH, GLA_RANK, N_GROUP_HEADS * GLA_DK), GLA_RANK ** -0.5)
    inp['gla_b_alpha'] = nrm((DEPTH, N_GROUP_HEADS * GLA_DK), 0.1)
    inp['gla_norm'] = 1.0 + nrm((DEPTH, GROUP_WIDTH), 0.05)
    inp['gmlp_ln_g'] = 1.0 + nrm((DEPTH, GROUP_WIDTH), 0.05)
    inp['gmlp_ln_b'] = nrm((DEPTH, GROUP_WIDTH), 0.05)
    inp['gmlp_ws'] = nrm((DEPTH, N_GROUP_HEADS, GMLP_CHUNK, GMLP_CHUNK), GMLP_CHUNK ** -0.5)
    inp['gmlp_bs'] = 1.0 + nrm((DEPTH, N_GROUP_HEADS, GMLP_CHUNK), 0.05)
    inp['rwkv_mu'] = unif((DEPTH, RWKV_COLS), 0.0, 1.0)
    inp['rwkv_w0'] = unif((DEPTH, GROUP_WIDTH), -6.5, -1.5)
    inp['rwkv_w2'] = nrm((DEPTH, RWKV_W_RANK, GROUP_WIDTH), 0.1)
    inp['rwkv_a0'] = nrm((DEPTH, GROUP_WIDTH), 0.1)
    inp['rwkv_a2'] = nrm((DEPTH, RWKV_A_RANK, GROUP_WIDTH), RWKV_A_RANK ** -0.5)
    inp['rwkv_g2'] = nrm((DEPTH, RWKV_G_RANK, GROUP_WIDTH), RWKV_G_RANK ** -0.5)
    inp['rwkv_kk'] = 0.85 + nrm((DEPTH, GROUP_WIDTH), 0.05)
    inp['rwkv_ka'] = 1.0 + nrm((DEPTH, GROUP_WIDTH), 0.05)
    inp['rwkv_rk'] = nrm((DEPTH, GROUP_WIDTH), 0.1)
    inp['rwkv_lnx_g'] = 1.0 + nrm((DEPTH, GROUP_WIDTH), 0.05)
    inp['rwkv_lnx_b'] = nrm((DEPTH, GROUP_WIDTH), 0.05)
    return inp


def reference(x_prompt, x_sample, cache_win128, cache_win512, cache_win2048, state_gla, state_rwkv, state_shift,
              norm_gains, w_ff_gate, w_ff_up, w_ff_down, w_in, w_out, gla_w_alpha2, gla_b_alpha, gla_norm,
              gmlp_ln_g, gmlp_ln_b, gmlp_ws, gmlp_bs, rwkv_mu, rwkv_w0, rwkv_w2, rwkv_a0, rwkv_a2, rwkv_g2,
              rwkv_kk, rwkv_ka, rwkv_rk, rwkv_lnx_g, rwkv_lnx_b):
    f32 = jnp.float32
    Bp = x_prompt.shape[0]
    caches = (cache_win128, cache_win512, cache_win2048)
    gla0 = jnp.zeros((Bp, N_GROUP_HEADS, GLA_DK, GLA_DV), f32)
    rwkv0 = jnp.zeros((Bp, N_GROUP_HEADS, RWKV_N, RWKV_N), f32)
    shift0 = jnp.zeros((Bp, RWKV_COLS), x_prompt.dtype)
    past0 = jnp.zeros((Bp, 0, 2, N_GROUP_HEADS, HEAD_DIM), x_prompt.dtype)
    yp, ys = x_prompt, x_sample
    pg, pr, psh, pw = [], [], [], [[], [], []]
    sg, sr, ssh, sw, sv = [], [], [], [[], [], []], []
    for l in range(DEPTH):
        p = dict(norms=norm_gains[l], ff_gate=w_ff_gate[l], ff_up=w_ff_up[l], ff_down=w_ff_down[l],
                 w_in=w_in[l], w_out=w_out[l], gla_w_alpha2=gla_w_alpha2[l], gla_b_alpha=gla_b_alpha[l],
                 gla_norm=gla_norm[l], gmlp_ln_g=gmlp_ln_g[l], gmlp_ln_b=gmlp_ln_b[l], gmlp_ws=gmlp_ws[l],
                 gmlp_bs=gmlp_bs[l], rwkv_mu=rwkv_mu[l], rwkv_w0=rwkv_w0[l], rwkv_w2=rwkv_w2[l],
                 rwkv_a0=rwkv_a0[l], rwkv_a2=rwkv_a2[l], rwkv_g2=rwkv_g2[l], rwkv_kk=rwkv_kk[l],
                 rwkv_ka=rwkv_ka[l], rwkv_rk=rwkv_rk[l], rwkv_lnx_g=rwkv_lnx_g[l], rwkv_lnx_b=rwkv_lnx_b[l])
        yp, g_p, r_p, sh_p, _, kv_p = trunk_layer(yp, p, gla0, rwkv0, shift0, [past0, past0, past0])
        ys, g_s, r_s, sh_s, v_s, kv_s = trunk_layer(ys, p, state_gla[l], state_rwkv[l], state_shift[l],
                                                    [c[l] for c in caches])
        pg.append(g_p)
        pr.append(r_p)
        psh.append(sh_p)
        sg.append(g_s)
        sr.append(r_s)
        ssh.append(sh_s)
        sv.append(v_s)
        for gi in range(DIL_N_GROUPS):
            pw[gi].append(kv_p[gi])
            sw[gi].append(kv_s[gi])
    return (yp, ys,
            jnp.stack(pg), jnp.stack(pr), jnp.stack(psh),
            jnp.stack(pw[0]), jnp.stack(pw[1]), jnp.stack(pw[2]),
            jnp.stack(sg), jnp.stack(sr), jnp.stack(ssh),
            jnp.stack(sw[0]), jnp.stack(sw[1]), jnp.stack(sw[2]),
            jnp.stack(sv))
```

```cpp
#include <hip/hip_runtime.h>
#include <hip/hip_cooperative_groups.h>
#include <cstdio>
namespace cg = cooperative_groups;
__device__ __forceinline__ int launder_v(int x) { asm volatile("" : "+v"(x)); return x; }
__device__ __forceinline__ int launder_s(int x) { asm volatile("" : "+s"(x)); return x; }
template <class T> __device__ __forceinline__ T* launder_p(T* p) { asm volatile("" : "+s"(p)); return p; }
namespace pg8 {
#define PG8_LAS __attribute__((address_space(3)))
typedef unsigned short bf16_t;
typedef short bf16x8 __attribute__((ext_vector_type(8)));
typedef float f32x4 __attribute__((ext_vector_type(4)));
typedef unsigned u32x4 __attribute__((ext_vector_type(4)));
constexpr int BM = 256, BK = 64, HALF = 128, HTB = HALF * BK * 2  , STAGE_BYTES = 8 * HTB, NXCD = 8, WGM = 8;

__host__ __device__ __forceinline__ int lds_byte(int r, int c) { const int st = (r >> 4) * 2 + (c >> 5), rr = r & 15, cc = c & 31, ob = rr * 64 + cc * 2; return st * 1024 + (ob ^ (((ob >> 9) & 1) << 5)); }
__host__ __device__ __forceinline__ void stage_rc(int b, int& R, int& C) { const int st = b / 1024, sb = b % 1024, swz = sb ^ (((sb >> 9) & 1) << 5); R = (st >> 1) * 16 + swz / 64; C = (st & 1) * 32 + (swz % 64) / 2; }
__host__ __device__ __forceinline__ int perm32(int rho) { const int n = rho >> 4, i = rho & 15; return 8 * (i >> 2) + 4 * n + (i & 3); }

struct Unit { int pm, pn; };
struct Gemm { const bf16_t* A; const bf16_t* Bt; int M, N, K; };

struct StaticOrder {
    int nM, nN, nwg, G, c;
    __host__ __device__ void init(int M, int N, int G_, int c_) { nM = M / BM; nN = N / BM; nwg = nM * nN; G = G_; c = c_; }
    __host__ __device__ bool next(int i, Unit& u) const {
        const long L = (long)i * G + c; if (L >= nwg) return false;
        int wgid = (int)L; { const int q = nwg / NXCD, r = nwg % NXCD, xcd = wgid % NXCD, off = wgid / NXCD; wgid = (xcd < r ? xcd * (q + 1) : r * (q + 1) + (xcd - r) * q) + off; }
        const int nig = WGM * nN, gid = wgid / nig, fm = gid * WGM, gsz = (nM - fm) < WGM ? (nM - fm) : WGM;
        u.pm = fm + ((wgid % nig) % gsz); u.pn = (wgid % nig) / gsz; return true;
    }
    __device__ __forceinline__ void a_ready(const Unit&) const {}
    __device__ __forceinline__ void done(const Unit&) const {}
};
__device__ __forceinline__ unsigned cvt_pk_bf16(float lo, float hi) { unsigned r; asm volatile("v_cvt_pk_bf16_f32 %0, %1, %2" : "=v"(r) : "v"(lo), "v"(hi)); return r; }
template <class Epi, class Sched, bool STAMP = false>
__device__ __forceinline__ void gemm_phase(PG8_LAS unsigned char* lds, const Gemm g, const Sched& S, const Epi& E, unsigned long long* stamps) {
    const int tid = launder_v(threadIdx.x), wid = __builtin_amdgcn_readfirstlane(tid >> 6), lane = tid & 63, wr = wid >> 2, wc = wid & 3, fr = lane & 15, fq = lane >> 4;
    const int K = g.K, nt = K / BK;
    int ts_lo = 0, ts_hi = 0, nts = 0; const unsigned long long rt_entry = STAMP ? (unsigned long long)wall_clock64() : 0ull;
#define PG8_STAMP() do { if (STAMP && wid == 0 && nts < 64) { const unsigned long long _c = (unsigned long long)clock64(); \
        ts_lo = (lane == nts) ? (int)(unsigned)_c : ts_lo; ts_hi = (lane == nts) ? (int)(unsigned)(_c >> 32) : ts_hi; ++nts; } } while (0)
    PG8_STAMP();
    unsigned voffA[2], voffB[2];
#pragma unroll
    for (int i = 0; i < 2; ++i) { int R, C; stage_rc(tid * 16 + i * 8192, R, C); const int Rb = Epi::PERM ? ((R & ~31) + perm32(R & 31)) : R;
        voffA[i] = (unsigned)(R * K + C) * 2u; voffB[i] = (unsigned)(Rb * K + C) * 2u; }
    const size_t kstep = (size_t)(BK * 2);
    const size_t hstep = (size_t)HALF * K * 2;
    const size_t tstep = 2 * hstep;
    const unsigned ldsw = (unsigned)wid * 1024u;
    const int aoff = lds_byte(wr * 64 + fr, fq * 8), boff = lds_byte(wc * 32 + fr, fq * 8);
#define PG8_SA(b, h) (((b) * 2 + (h)) * HTB)
#define PG8_SB(b, h) ((4 + (b) * 2 + (h)) * HTB)
#define PG8_STAGE(bufoff, gbase, voff) do { _Pragma("unroll") for (int _i = 0; _i < 2; ++_i) \
        __builtin_amdgcn_global_load_lds((const unsigned*)((const char*)(gbase) + (voff)[_i]), (PG8_LAS unsigned*)(lds + (bufoff) + ldsw + _i * 8192), 16, 0, 0); } while (0)
#define PG8_LDA(dst, b, h) do { _Pragma("unroll") for (int m = 0; m < 4; ++m) _Pragma("unroll") for (int k = 0; k < 2; ++k) dst[m][k] = *(const PG8_LAS bf16x8*)(lds + PG8_SA(b, h) + aoff + m * 2048 + k * 1024); } while (0)
#define PG8_LDB(dst, b, h) do { _Pragma("unroll") for (int n = 0; n < 2; ++n) _Pragma("unroll") for (int k = 0; k < 2; ++k) dst[n][k] = *(const PG8_LAS bf16x8*)(lds + PG8_SB(b, h) + boff + n * 2048 + k * 1024); } while (0)
#define PG8_MMA(ai, bj, At, Bt) do { __builtin_amdgcn_s_setprio(1); _Pragma("unroll") for (int m = 0; m < 4; ++m) _Pragma("unroll") for (int n = 0; n < 2; ++n) _Pragma("unroll") for (int k = 0; k < 2; ++k) \
        acc[ai][bj][m][n] = __builtin_amdgcn_mfma_f32_16x16x32_bf16(Bt[n][k], At[m][k], acc[ai][bj][m][n], 0, 0, 0); __builtin_amdgcn_s_setprio(0); } while (0)
#define PG8_WAIT_V(n) asm volatile("s_waitcnt vmcnt(" #n ")" ::: "memory")
#define PG8_WAIT_L(n) asm volatile("s_waitcnt lgkmcnt(" #n ")" ::: "memory")
#define PG8_BAR __builtin_amdgcn_s_barrier()
#define PG8_SCHED __builtin_amdgcn_sched_barrier(0)
    Unit cur, nxt; int ui = 0;
    if (!S.next(0, cur)) return;
    f32x4 acc[2][2][4][2];
#pragma unroll
    for (int a = 0; a < 2; ++a)
#pragma unroll
        for (int b = 0; b < 2; ++b)
#pragma unroll
            for (int m = 0; m < 4; ++m)
#pragma unroll
                for (int n = 0; n < 2; ++n) acc[a][b][m][n] = (f32x4){0.f, 0.f, 0.f, 0.f};
    bf16x8 At[4][2], B0[2][2], B1[2][2];
    const char* cA = (const char*)g.A + (size_t)cur.pm * tstep; const char* cB = (const char*)g.Bt + (size_t)cur.pn * tstep;
    S.a_ready(cur);
    PG8_STAGE(PG8_SB(0, 0), cB, voffB); PG8_STAGE(PG8_SA(0, 0), cA, voffA); PG8_STAGE(PG8_SB(0, 1), cB + hstep, voffB); PG8_STAGE(PG8_SA(0, 1), cA + hstep, voffA);
    if (wr == 1) PG8_BAR;
    PG8_WAIT_V(4); PG8_BAR;
    PG8_STAGE(PG8_SB(1, 0), cB + kstep, voffB); PG8_STAGE(PG8_SA(1, 0), cA + kstep, voffA); PG8_STAGE(PG8_SB(1, 1), cB + hstep + kstep, voffB);
    PG8_WAIT_V(6); PG8_BAR;
    PG8_STAMP();
    for (;;) {
        const bool has_next = S.next(ui + 1, nxt);
        const char* nA = has_next ? (const char*)g.A + (size_t)nxt.pm * tstep : cA; const char* nB = has_next ? (const char*)g.Bt + (size_t)nxt.pn * tstep : cB;
        for (int t = 0; t < nt; t += 2) {
            const bool last = (t == nt - 2);
            const char* a1 = cA + (size_t)(t + 1) * kstep;
            const char* a2 = last ? nA : cA + (size_t)(t + 2) * kstep; const char* b2 = last ? nB : cB + (size_t)(t + 2) * kstep;
            const char* a3 = a2 + kstep; const char* b3 = b2 + kstep;
            if (last && has_next) S.a_ready(nxt);
            PG8_LDB(B0, 0, 0); PG8_SCHED; PG8_LDA(At, 0, 0); PG8_STAGE(PG8_SA(1, 1), a1 + hstep, voffA);
            PG8_WAIT_L(8); PG8_BAR; PG8_WAIT_L(0); PG8_MMA(0, 0, At, B0); PG8_BAR; PG8_SCHED;
            PG8_LDB(B1, 0, 1); PG8_STAGE(PG8_SB(0, 0), b2, voffB);
            PG8_BAR; PG8_WAIT_L(0); PG8_MMA(0, 1, At, B1); PG8_BAR;
            PG8_LDA(At, 0, 1); PG8_STAGE(PG8_SA(0, 0), a2, voffA);
            PG8_BAR; PG8_WAIT_L(0); PG8_MMA(1, 0, At, B0); PG8_BAR; PG8_SCHED;
            PG8_STAGE(PG8_SB(0, 1), b2 + hstep, voffB);
            PG8_WAIT_V(6); PG8_BAR; PG8_MMA(1, 1, At, B1); PG8_BAR;
            PG8_LDB(B0, 1, 0); PG8_SCHED; PG8_LDA(At, 1, 0); PG8_STAGE(PG8_SA(0, 1), a2 + hstep, voffA);
            PG8_WAIT_L(8); PG8_BAR; PG8_WAIT_L(0); PG8_MMA(0, 0, At, B0); PG8_BAR; PG8_SCHED;
            PG8_LDB(B1, 1, 1); PG8_STAGE(PG8_SB(1, 0), b3, voffB);
            PG8_BAR; PG8_WAIT_L(0); PG8_MMA(0, 1, At, B1); PG8_BAR;
            PG8_LDA(At, 1, 1); PG8_STAGE(PG8_SA(1, 0), a3, voffA);
            PG8_BAR; PG8_WAIT_L(0); PG8_MMA(1, 0, At, B0); PG8_BAR; PG8_SCHED;
            PG8_STAGE(PG8_SB(1, 1), b3 + hstep, voffB);
            PG8_WAIT_V(6); PG8_BAR; PG8_MMA(1, 1, At, B1); PG8_BAR;
        }
        PG8_STAMP();
        if constexpr (!Epi::AFTER_DRAIN) { E(acc, cur, wr, wc, fr, fq); S.done(cur); }
        PG8_STAMP();
        if (!has_next) break;
#pragma unroll
        for (int a = 0; a < 2; ++a)
#pragma unroll
            for (int b = 0; b < 2; ++b)
#pragma unroll
                for (int m = 0; m < 4; ++m)
#pragma unroll
                    for (int n = 0; n < 2; ++n) acc[a][b][m][n] = (f32x4){0.f, 0.f, 0.f, 0.f};
        cur = nxt; cA = nA; cB = nB; ++ui;
    }
    PG8_WAIT_V(0);
    if (wr == 0) PG8_BAR;
    PG8_BAR;
    if constexpr (Epi::AFTER_DRAIN) { E.fused(acc, cur, wr, wc, fr, fq, lds, wid, lane); S.done(cur); }
    PG8_STAMP();
    if (STAMP && wid == 0) { stamps[lane] = lane < nts ? (((unsigned long long)(unsigned)ts_hi << 32) | (unsigned)ts_lo) : 0ull;
        if (lane == 62) stamps[62] = rt_entry; if (lane == 63) stamps[63] = (unsigned long long)wall_clock64(); }
#undef PG8_STAMP
#undef PG8_SA
#undef PG8_SB
#undef PG8_STAGE
#undef PG8_LDA
#undef PG8_LDB
#undef PG8_MMA
#undef PG8_WAIT_V
#undef PG8_WAIT_L
#undef PG8_BAR
#undef PG8_SCHED
}
}

using pg8::bf16_t; using pg8::bf16x8; using pg8::f32x4;
constexpr int MR = 16512, MPAD = 16640;
constexpr int NINP = 4864;
constexpr int C_GLA = 0, C_GMLP = 784, C_RWKV = 1296, C_DIL = 2320;
constexpr float EPS = 1e-6f;

constexpr size_t SZ_WGU1 = (size_t)5632 * 1024 * 2, SZ_WD1 = (size_t)1024 * 2816 * 2, SZ_WIN1 = (size_t)NINP * 1024 * 2, SZ_WOUT1 = (size_t)1024 * 1024 * 2;
constexpr size_t O_WGU = 0;
constexpr size_t O_WD = O_WGU + 4 * SZ_WGU1;
constexpr size_t O_WIN = O_WD + 4 * SZ_WD1;
constexpr size_t O_WOUT = O_WIN + 2 * SZ_WIN1;
constexpr size_t O_XN = O_WOUT + 2 * SZ_WOUT1;
constexpr size_t O_ACT = O_XN + (size_t)MPAD * 1024 * 2;
constexpr size_t O_F = O_ACT + (size_t)MPAD * 2816 * 2;
constexpr size_t O_H = O_F + (size_t)MPAD * 1024 * 4;
constexpr size_t O_COLS = O_H + (size_t)MR * 1024 * 4;
constexpr size_t O_MIX = O_COLS + (size_t)MPAD * NINP * 2;
constexpr size_t O_SSP = O_MIX + (size_t)MPAD * 1024 * 2;
constexpr size_t O_SSPT = O_SSP + (size_t)16384 * 16 * 4;
constexpr size_t O_LSE = O_SSPT + (size_t)128 * 32 * 4;
constexpr size_t O_BON = O_LSE + (size_t)3 * MR * 4 * 4;
constexpr size_t O_CTR = O_BON + (size_t)MR * 4 * 4;
constexpr size_t WS_END = O_CTR + 256;
constexpr size_t SZ_RW = (size_t)MR * 256 * 4;
constexpr size_t O_RR = O_ACT, O_RWD = O_ACT + SZ_RW, O_RK = O_ACT + 2 * SZ_RW, O_RV = O_ACT + 3 * SZ_RW, O_RG = O_ACT + 4 * SZ_RW;
constexpr size_t O_RA = O_F, O_RB = O_F + SZ_RW, O_RY = O_F + 2 * SZ_RW;
constexpr size_t O_DILO = O_XN;
static_assert(5 * SZ_RW <= (size_t)MPAD * 2816 * 2, "rwkv alias");
static_assert(3 * SZ_RW <= (size_t)MPAD * 1024 * 4, "rwkv alias 2");
static_assert((size_t)3 * MR * 256 * 2 <= (size_t)MR * 1024 * 2, "dilo alias");

constexpr size_t OUT_YP = 0;
constexpr size_t OUT_YS = OUT_YP + (size_t)8 * 2048 * 1024;
constexpr size_t OUT_PGLA = OUT_YS + (size_t)32 * 4 * 1024;
constexpr size_t OUT_PRWKV = OUT_PGLA + (size_t)2 * 8 * 4 * 32 * 64;
constexpr size_t OUT_PSHIFT = OUT_PRWKV + (size_t)2 * 8 * 4 * 64 * 64;
constexpr size_t OUT_PW128 = OUT_PSHIFT + (size_t)2 * 8 * 1024;
constexpr size_t OUT_PW512 = OUT_PW128 + (size_t)2 * 8 * 128 * 512;
constexpr size_t OUT_PW2048 = OUT_PW512 + (size_t)2 * 8 * 512 * 512;
constexpr size_t OUT_SGLA = OUT_PW2048 + (size_t)2 * 8 * 2048 * 512;
constexpr size_t OUT_SRWKV = OUT_SGLA + (size_t)2 * 32 * 4 * 32 * 64;
constexpr size_t OUT_SSHIFT = OUT_SRWKV + (size_t)2 * 32 * 4 * 64 * 64;
constexpr size_t OUT_SW128 = OUT_SSHIFT + (size_t)2 * 32 * 1024;
constexpr size_t OUT_SW512 = OUT_SW128 + (size_t)2 * 32 * 4 * 512;
constexpr size_t OUT_SW2048 = OUT_SW512 + (size_t)2 * 32 * 4 * 512;
constexpr size_t OUT_SGV = OUT_SW2048 + (size_t)2 * 32 * 4 * 512;
constexpr size_t OUT_END = OUT_SGV + (size_t)2 * 32 * 4 * 256;

constexpr int LDS_BYTES = 131072;

struct Params { const float* in[32]; float* out; unsigned char* ws; int ph_lo, ph_hi; };
struct Ctx { const float* const* in; float* out; unsigned char* ws; };

__device__ __forceinline__ float bf2f(bf16_t b) { return __uint_as_float(((unsigned)b) << 16); }
__device__ __forceinline__ bf16_t f2bf(float f) { unsigned u = __float_as_uint(f); u += 0x7FFFu + ((u >> 16) & 1u); return (bf16_t)(u >> 16); }
__device__ __forceinline__ unsigned pack2(float lo, float hi) { return (unsigned)f2bf(lo) | ((unsigned)f2bf(hi) << 16); }
__device__ __forceinline__ float wave_sum(float x) {
#pragma unroll
    for (int o = 32; o > 0; o >>= 1) x += __shfl_xor(x, o);
    return x;
}
__device__ __forceinline__ float wave_max(float x) {
#pragma unroll
    for (int o = 32; o > 0; o >>= 1) x = fmaxf(x, __shfl_xor(x, o));
    return x;
}
template <int CTRL> __device__ __forceinline__ float dppf(float x) { return __builtin_bit_cast(float, __builtin_amdgcn_mov_dpp(__builtin_bit_cast(int, x), CTRL, 0xf, 0xf, true)); }
__device__ __forceinline__ float red4_sum(float x) { x += dppf<0xB1>(x); x += dppf<0x4E>(x); return x; }
__device__ __forceinline__ float red8_sum(float x) { x += dppf<0xB1>(x); x += dppf<0x4E>(x); x += dppf<0x141>(x); return x; }
__device__ __forceinline__ float red16_sum(float x) { x += dppf<0xB1>(x); x += dppf<0x4E>(x); x += dppf<0x141>(x); x += dppf<0x128>(x); return x; }
__device__ __forceinline__ float red16_max(float x) { x = fmaxf(x, dppf<0xB1>(x)); x = fmaxf(x, dppf<0x4E>(x)); x = fmaxf(x, dppf<0x141>(x)); x = fmaxf(x, dppf<0x128>(x)); return x; }
__device__ __forceinline__ float sigm(float x) { return 1.f / (1.f + __expf(-x)); }
__device__ __forceinline__ float gelu_e(float v) {
    const float av = fabsf(v), t = __builtin_amdgcn_rcpf(av * 0.2316418882f + 1.0f);
    float q = t * 0.5307027145f + (-0.7265760135f); q = q * t + 0.7107068705f; q = q * t + (-0.142248368f); q = q * t + 0.127414796f; q = q * t;
    const float e = __builtin_amdgcn_exp2f(v * v * (-0.72134752044f)), m = v * (q * e);
    return v < 0.f ? m : v - m;
}
__device__ __forceinline__ float silu_f(float x) { return x / (1.f + __expf(-x)); }
__device__ __forceinline__ bf16x8 ldfrag(const bf16_t* base, int ld, int row0, int k0, int lane) { return *(const bf16x8*)(base + (row0 + (lane & 15)) * ld + k0 + (lane >> 4) * 8); }
__device__ __forceinline__ f32x4 mma16(bf16x8 a, bf16x8 b, f32x4 c) { return __builtin_amdgcn_mfma_f32_16x16x32_bf16(a, b, c, 0, 0, 0); }

struct EpiSwiGLU {
    static constexpr bool PERM = true, AFTER_DRAIN = false;
    bf16_t* O;
    __device__ __forceinline__ void operator()(const f32x4 (&acc)[2][2][4][2], const pg8::Unit& u, int wr, int wc, int fr, int fq) const {
        const int row0 = u.pm * 256 + wr * 64 + fr, col0 = u.pn * 128 + wc * 32 + 8 * fq;
#pragma unroll
        for (int ai = 0; ai < 2; ++ai)
#pragma unroll
            for (int m = 0; m < 4; ++m) {
                bf16_t* rowp = O + (size_t)(row0 + ai * 128 + m * 16) * 2816 + col0;
                const f32x4 g0 = acc[ai][0][m][0], g1 = acc[ai][0][m][1], u0 = acc[ai][1][m][0], u1 = acc[ai][1][m][1];
                float r[8];
#pragma unroll
                for (int i = 0; i < 4; ++i) { r[i] = silu_f(g0[i]) * u0[i]; r[4 + i] = silu_f(g1[i]) * u1[i]; }
                uint4 w; w.x = pack2(r[0], r[1]); w.y = pack2(r[2], r[3]); w.z = pack2(r[4], r[5]); w.w = pack2(r[6], r[7]);
                *(uint4*)rowp = w;
            }
    }
};
struct EpiBf16P {
    static constexpr bool PERM = true, AFTER_DRAIN = false;
    bf16_t* O; int ldc;
    __device__ __forceinline__ void operator()(const f32x4 (&acc)[2][2][4][2], const pg8::Unit& u, int wr, int wc, int fr, int fq) const {
        const int row0 = u.pm * 256 + wr * 64 + fr, col0 = u.pn * 256 + wc * 32 + 8 * fq;
#pragma unroll
        for (int ai = 0; ai < 2; ++ai)
#pragma unroll
            for (int m = 0; m < 4; ++m) {
                bf16_t* rowp = O + (size_t)(row0 + ai * 128 + m * 16) * ldc + col0;
#pragma unroll
                for (int bj = 0; bj < 2; ++bj) {
                    const f32x4 v0 = acc[ai][bj][m][0], v1 = acc[ai][bj][m][1];
                    uint4 w; w.x = pack2(v0[0], v0[1]); w.y = pack2(v0[2], v0[3]); w.z = pack2(v1[0], v1[1]); w.w = pack2(v1[2], v1[3]);
                    *(uint4*)(rowp + bj * 128) = w;
                }
            }
    }
};
struct EpiF32SS {
    static constexpr bool PERM = false, AFTER_DRAIN = false;
    float* C; float* ssp;
    __device__ __forceinline__ void operator()(const f32x4 (&acc)[2][2][4][2], const pg8::Unit& u, int wr, int wc, int fr, int fq) const {
        const int row0 = u.pm * 256 + wr * 64 + fr, col0 = u.pn * 256 + wc * 32 + 4 * fq;
#pragma unroll
        for (int ai = 0; ai < 2; ++ai)
#pragma unroll
            for (int m = 0; m < 4; ++m) {
                const int row = row0 + ai * 128 + m * 16;
                float* rowp = C + (size_t)row * 1024 + col0;
                float s = 0.f;
#pragma unroll
                for (int bj = 0; bj < 2; ++bj)
#pragma unroll
                    for (int n = 0; n < 2; ++n) { const f32x4 x = acc[ai][bj][m][n]; *(f32x4*)(rowp + bj * 128 + n * 16) = x; s += (x[0] * x[0] + x[1] * x[1]) + (x[2] * x[2] + x[3] * x[3]); }
                s += __shfl_xor(s, 16); s += __shfl_xor(s, 32);
                if (fq == 0) ssp[(size_t)row * 16 + u.pn * 4 + wc] = s;
            }
    }
};

__device__ __forceinline__ void cvt_tile(const float* __restrict__ src, int ldn, int nvalid, int k0, int n0, bf16_t* __restrict__ dst, int K, int drow0, float* sT) {
    const int tid = threadIdx.x;
#pragma unroll
    for (int i = 0; i < 8; ++i) { const int kk = i * 8 + (tid >> 6), nn = tid & 63, n = n0 + nn; sT[kk * 65 + nn] = (n < nvalid) ? src[(size_t)(k0 + kk) * ldn + n] : 0.f; }
    __syncthreads();
    const int nl = tid >> 3, kg = tid & 7;
    float v[8];
#pragma unroll
    for (int j = 0; j < 8; ++j) v[j] = sT[(kg * 8 + j) * 65 + nl];
    uint4 w; w.x = pack2(v[0], v[1]); w.y = pack2(v[2], v[3]); w.z = pack2(v[4], v[5]); w.w = pack2(v[6], v[7]);
    *(uint4*)(dst + (size_t)(drow0 + nl) * K + k0 + kg * 8) = w;
    __syncthreads();
}

__device__ __forceinline__ void phase_prologue(const Ctx& p, unsigned char* smem) {
    const int tid = launder_v(threadIdx.x), bid = blockIdx.x, nb = gridDim.x;
    float* sT = (float*)smem;
    for (int t = bid; t < 11392; t += nb) {
        const float* src; bf16_t* dst; int ldn, nvalid, K, k0, n0, drow0;
        if (t < 8448) {
            const int blk = t / 2112, r = t % 2112, which = r / 704, tt = r % 704;
            if (which < 2) { src = p.in[9 + which] + (size_t)blk * 1024 * 2816; ldn = 2816; nvalid = 2816; K = 1024; k0 = (tt / 44) * 64; n0 = (tt % 44) * 64;
                dst = (bf16_t*)(p.ws + O_WGU + blk * SZ_WGU1); drow0 = (n0 >> 7) * 256 + (n0 & 127) + which * 128; }
            else { src = p.in[11] + (size_t)blk * 2816 * 1024; ldn = 1024; nvalid = 1024; K = 2816; k0 = (tt / 16) * 64; n0 = (tt % 16) * 64;
                dst = (bf16_t*)(p.ws + O_WD + blk * SZ_WD1); drow0 = n0; }
        } else if (t < 10880) {
            const int u = t - 8448, l = u / 1216, tt = u % 1216;
            src = p.in[12] + (size_t)l * 1024 * 4624; ldn = 4624; nvalid = 4624; K = 1024; k0 = (tt / 76) * 64; n0 = (tt % 76) * 64;
            dst = (bf16_t*)(p.ws + O_WIN + l * SZ_WIN1); drow0 = n0;
        } else {
            const int u = t - 10880, l = u / 256, tt = u % 256;
            src = p.in[13] + (size_t)l * 1024 * 1024; ldn = 1024; nvalid = 1024; K = 1024; k0 = (tt / 16) * 64; n0 = (tt % 16) * 64;
            dst = (bf16_t*)(p.ws + O_WOUT + l * SZ_WOUT1); drow0 = n0;
        }
        cvt_tile(src, ldn, nvalid, k0, n0, dst, K, drow0, sT);
    }
    const int wave = tid >> 6, lane = tid & 63;
    const float* g0 = p.in[8];
    bf16_t* XN = (bf16_t*)(p.ws + O_XN); bf16_t* MIX = (bf16_t*)(p.ws + O_MIX);
    for (int row = bid * 8 + wave; row < MPAD; row += nb * 8) {
        bf16_t* xo = XN + (size_t)row * 1024;
        if (row < MR) {
            const float* x = row < 16384 ? p.in[0] + (size_t)row * 1024 : p.in[1] + (size_t)(row - 16384) * 1024;
            float4 v[4]; float ss = 0.f;
#pragma unroll
            for (int j = 0; j < 4; ++j) { v[j] = *(const float4*)(x + j * 256 + lane * 4); ss += v[j].x * v[j].x + v[j].y * v[j].y + v[j].z * v[j].z + v[j].w * v[j].w; }
            ss = wave_sum(ss);
            const float rs = rsqrtf(ss * (1.f / 1024.f) + EPS);
#pragma unroll
            for (int j = 0; j < 4; ++j) { const float4 g = *(const float4*)(g0 + j * 256 + lane * 4);
                uint2 o; o.x = pack2(v[j].x * rs * g.x, v[j].y * rs * g.y); o.y = pack2(v[j].z * rs * g.z, v[j].w * rs * g.w);
                *(uint2*)(xo + j * 256 + lane * 4) = o; }
        } else {
            bf16_t* mo = MIX + (size_t)row * 1024;
#pragma unroll
            for (int j = 0; j < 4; ++j) { *(uint2*)(xo + j * 256 + lane * 4) = make_uint2(0u, 0u); *(uint2*)(mo + j * 256 + lane * 4) = make_uint2(0u, 0u); }
        }
    }
    if (bid == 0 && tid < 64) ((unsigned*)(p.ws + O_CTR))[tid] = 0u;
}

__device__ __forceinline__ void phase_ew(const Ctx& p, int l, int kind) {
    const int tid = launder_v(threadIdx.x), wave = tid >> 6, lane = tid & 63;
    const float* ng = p.in[8] + (size_t)l * 6 * 1024;
    const float* gpost = ng + (kind == 0 ? 1 : (kind == 1 ? 3 : 5)) * 1024;
    const float* gpre = kind == 0 ? ng + 2 * 1024 : (kind == 1 ? ng + 4 * 1024 : (l == 0 ? p.in[8] + 6 * 1024 : nullptr));
    const float scale = kind == 1 ? 1.f : 0.5f;
    float* H = (float*)(p.ws + O_H); const float* F = (const float*)(p.ws + O_F);
    const float* SSP = (const float*)(p.ws + O_SSP); const float* SSPT = (const float*)(p.ws + O_SSPT);
    bf16_t* XN = (bf16_t*)(p.ws + O_XN);
    for (int row = blockIdx.x * 8 + wave; row < MR; row += gridDim.x * 8) {
        float ss;
        if (row < 16384) ss = lane < 16 ? SSP[(size_t)row * 16 + lane] : 0.f; else ss = lane < 32 ? SSPT[(size_t)(row - 16384) * 32 + lane] : 0.f;
        ss = wave_sum(ss);
        const float rs = rsqrtf(ss * (1.f / 1024.f) + EPS) * scale;
        const float* res = (kind == 0 && l == 0) ? (row < 16384 ? p.in[0] + (size_t)row * 1024 : p.in[1] + (size_t)(row - 16384) * 1024) : H + (size_t)row * 1024;
        float* dst = (kind == 2 && l == 1) ? p.out + (size_t)row * 1024 : H + (size_t)row * 1024;
        float4 hv[4]; float s2 = 0.f;
#pragma unroll
        for (int j = 0; j < 4; ++j) {
            const int c = j * 256 + lane * 4;
            const float4 f = *(const float4*)(F + (size_t)row * 1024 + c), g = *(const float4*)(gpost + c), r = *(const float4*)(res + c);
            float4 h; h.x = r.x + f.x * rs * g.x; h.y = r.y + f.y * rs * g.y; h.z = r.z + f.z * rs * g.z; h.w = r.w + f.w * rs * g.w;
            hv[j] = h; s2 += h.x * h.x + h.y * h.y + h.z * h.z + h.w * h.w;
            *(float4*)(dst + c) = h;
        }
        if (gpre) {
            s2 = wave_sum(s2);
            const float r2 = rsqrtf(s2 * (1.f / 1024.f) + EPS);
#pragma unroll
            for (int j = 0; j < 4; ++j) { const int c = j * 256 + lane * 4; const float4 g = *(const float4*)(gpre + c);
                uint2 o; o.x = pack2(hv[j].x * r2 * g.x, hv[j].y * r2 * g.y); o.y = pack2(hv[j].z * r2 * g.z, hv[j].w * r2 * g.w);
                *(uint2*)(XN + (size_t)row * 1024 + c) = o; }
        }
    }
}

__device__ __forceinline__ void tail_gemm(const bf16_t* __restrict__ A, const bf16_t* __restrict__ Bt, int K, float* __restrict__ F, float* __restrict__ SSPT, unsigned char* smem) {
    const int tid = launder_v(threadIdx.x), wave = tid >> 6, lane = tid & 63, fr = lane & 15, fq = lane >> 4;
    float* red = (float*)smem;
    for (int item = blockIdx.x; item < 256; item += gridDim.x) {
        const int rg = item >> 5, cgp = item & 31;
        const bf16_t* Ap = A + (size_t)(16384 + rg * 16 + fr) * K + fq * 8;
        const bf16_t* B0 = Bt + (size_t)(cgp * 32 + fr) * K + fq * 8;
        const bf16_t* B1 = B0 + (size_t)16 * K;
        const int kper = K >> 3, kbeg = wave * kper;
        f32x4 acc0 = {0.f, 0.f, 0.f, 0.f}, acc1 = {0.f, 0.f, 0.f, 0.f};
        for (int k = kbeg; k < kbeg + kper; k += 32) {
            const bf16x8 a = *(const bf16x8*)(Ap + k), b0 = *(const bf16x8*)(B0 + k), b1 = *(const bf16x8*)(B1 + k);
            acc0 = mma16(a, b0, acc0); acc1 = mma16(a, b1, acc1);
        }
#pragma unroll
        for (int j = 0; j < 4; ++j) { red[wave * 512 + (fq * 4 + j) * 32 + fr] = acc0[j]; red[wave * 512 + (fq * 4 + j) * 32 + 16 + fr] = acc1[j]; }
        __syncthreads();
        float s = 0.f;
#pragma unroll
        for (int w = 0; w < 8; ++w) s += red[w * 512 + tid];
        const int row = tid >> 5, col = tid & 31;
        F[(size_t)(16384 + rg * 16 + row) * 1024 + cgp * 32 + col] = s;
        float q = s * s;
        q += __shfl_xor(q, 1); q += __shfl_xor(q, 2); q += __shfl_xor(q, 4); q += __shfl_xor(q, 8); q += __shfl_xor(q, 16);
        if (col == 0) SSPT[(rg * 16 + row) * 32 + cgp] = q;
        __syncthreads();
    }
}

__device__ __forceinline__ void phase_mixer_pre(const Ctx& p, int l, unsigned char* smem) {
    const int tid = launder_v(threadIdx.x), lane = tid & 63;
    float* xr = (float*)smem;
    float* lrT = xr + 16 * 768;
    const bf16_t* COLS = (const bf16_t*)(p.ws + O_COLS);
    const float* mu = p.in[21] + l * 1024;
    float* RR = (float*)(p.ws + O_RR); float* RWD = (float*)(p.ws + O_RWD); float* RK = (float*)(p.ws + O_RK); float* RV = (float*)(p.ws + O_RV);
    float* RG = (float*)(p.ws + O_RG); float* RA = (float*)(p.ws + O_RA); float* RB = (float*)(p.ws + O_RB); float* BON = (float*)(p.ws + O_BON);
    const float* w2 = p.in[23] + (size_t)l * 64 * 256; const float* a2 = p.in[25] + (size_t)l * 64 * 256; const float* g2 = p.in[26] + (size_t)l * 128 * 256;
    for (int item = blockIdx.x; item < MR / 16; item += gridDim.x) {
        const int r0 = item * 16;
        for (int i = 0; i < 32; ++i) {
            const int idx = tid + i * 512, tok = idx >> 10, c = idx & 1023, row = r0 + tok;
            const float cv = bf2f(COLS[(size_t)row * NINP + C_RWKV + c]);
            float pv; bool last; float* shout;
            if (row < 16384) { const int t = row & 2047, b = row >> 11; pv = t > 0 ? bf2f(COLS[(size_t)(row - 1) * NINP + C_RWKV + c]) : 0.f; last = (t == 2047); shout = p.out + OUT_PSHIFT + (size_t)(l * 8 + b) * 1024 + c; }
            else { const int rr = row - 16384, t = rr & 3, b = rr >> 2; pv = t > 0 ? bf2f(COLS[(size_t)(row - 1) * NINP + C_RWKV + c]) : p.in[7][(size_t)(l * 32 + b) * 1024 + c]; last = (t == 3); shout = p.out + OUT_SSHIFT + (size_t)(l * 32 + b) * 1024 + c; }
            if (last) *shout = cv;
            const float xm = cv + (pv - cv) * mu[c];
            if (c < 768) xr[tok * 768 + c] = xm;
            else if (c < 832) lrT[(c - 768) * 16 + tok] = tanhf(xm);
            else if (c < 896) lrT[(64 + c - 832) * 16 + tok] = xm;
            else lrT[(128 + c - 896) * 16 + tok] = sigm(xm);
        }
        for (int i = 0; i < 48; ++i) {
            const int idx = tid + i * 512, tok = idx / 1536, rem = idx % 1536, gi = rem >> 9, cc = rem & 511, row = r0 + tok;
            const float v = bf2f(COLS[(size_t)row * NINP + C_DIL + gi * 768 + 256 + cc]);
            if (row < 16384) {
                const int t = row & 2047, b = row >> 11, W = gi == 0 ? 128 : (gi == 1 ? 512 : 2048);
                const size_t base = gi == 0 ? OUT_PW128 : (gi == 1 ? OUT_PW512 : OUT_PW2048);
                if (t >= 2048 - W) p.out[base + ((size_t)(l * 8 + b) * W + (t - (2048 - W))) * 512 + cc] = v;
            } else {
                const int rr = row - 16384, t = rr & 3, b = rr >> 2;
                const size_t base = gi == 0 ? OUT_SW128 : (gi == 1 ? OUT_SW512 : OUT_SW2048);
                p.out[base + ((size_t)(l * 32 + b) * 4 + t) * 512 + cc] = v;
            }
        }
        __syncthreads();
        const int col = tid & 255, half = tid >> 8, tok0 = half * 8, head = col >> 6;
        float wp[8], ap[8], gp[8];
#pragma unroll
        for (int j = 0; j < 8; ++j) { wp[j] = 0.f; ap[j] = 0.f; gp[j] = 0.f; }
        for (int k = 0; k < 64; ++k) {
            const float wv = w2[k * 256 + col], av = a2[k * 256 + col];
            const float4 t0 = *(const float4*)(lrT + k * 16 + tok0), t1 = *(const float4*)(lrT + k * 16 + tok0 + 4);
            const float4 u0 = *(const float4*)(lrT + (64 + k) * 16 + tok0), u1 = *(const float4*)(lrT + (64 + k) * 16 + tok0 + 4);
            wp[0] += wv * t0.x; wp[1] += wv * t0.y; wp[2] += wv * t0.z; wp[3] += wv * t0.w; wp[4] += wv * t1.x; wp[5] += wv * t1.y; wp[6] += wv * t1.z; wp[7] += wv * t1.w;
            ap[0] += av * u0.x; ap[1] += av * u0.y; ap[2] += av * u0.z; ap[3] += av * u0.w; ap[4] += av * u1.x; ap[5] += av * u1.y; ap[6] += av * u1.z; ap[7] += av * u1.w;
        }
        for (int k = 0; k < 128; ++k) {
            const float gv = g2[k * 256 + col];
            const float4 t0 = *(const float4*)(lrT + (128 + k) * 16 + tok0), t1 = *(const float4*)(lrT + (128 + k) * 16 + tok0 + 4);
            gp[0] += gv * t0.x; gp[1] += gv * t0.y; gp[2] += gv * t0.z; gp[3] += gv * t0.w; gp[4] += gv * t1.x; gp[5] += gv * t1.y; gp[6] += gv * t1.z; gp[7] += gv * t1.w;
        }
        const float w0c = p.in[22][l * 256 + col], a0c = p.in[24][l * 256 + col], kkc = p.in[27][l * 256 + col], kac = p.in[28][l * 256 + col], rkc = p.in[29][l * 256 + col];
#pragma unroll
        for (int j = 0; j < 8; ++j) {
            const int tok = tok0 + j; const size_t row = (size_t)(r0 + tok);
            const float r = xr[tok * 768 + col], kx = xr[tok * 768 + 256 + col], v = xr[tok * 768 + 512 + col];
            const float z = -(w0c + wp[j]);
            const float w = -(fmaxf(z, 0.f) + log1pf(__expf(-fabsf(z)))) - 0.5f;
            const float decay = __expf(-__expf(w));
            const float a = sigm(a0c + ap[j]);
            const float kk = kx * kkc;
            const float ssq = wave_sum(kk * kk);
            const float kkn = kk / fmaxf(sqrtf(ssq), 1e-12f);
            const float kp = kx * (1.f + (a - 1.f) * kac);
            const float bon = wave_sum(r * kp * rkc);
            RR[row * 256 + col] = r; RWD[row * 256 + col] = decay; RK[row * 256 + col] = kp; RV[row * 256 + col] = v;
            RA[row * 256 + col] = -kkn; RB[row * 256 + col] = kkn * a; RG[row * 256 + col] = gp[j];
            if (lane == 0) BON[row * 4 + head] = bon;
        }
        __syncthreads();
    }
}

__device__ __forceinline__ void rwkv_item(const Ctx& p, int l, int sample, int b, int h, int rq, unsigned char* smem) {
    const int tid = launder_v(threadIdx.x), wave = tid >> 6, lane = tid & 63;
    const int T = sample ? 4 : 2048, CT = sample ? 4 : 32, nch = T / CT;
    const size_t rowg0 = sample ? (size_t)(16384 + b * 4) : (size_t)b * 2048;
    float* vec = (float*)smem;
    float* vb = vec + 2 * 5 * 32 * 64;
    float* yb = vb + 2 * 32 * 16;
    const float* arr[5] = {(const float*)(p.ws + O_RA), (const float*)(p.ws + O_RWD), (const float*)(p.ws + O_RK), (const float*)(p.ws + O_RB), (const float*)(p.ws + O_RR)};
    const float* RV = (const float*)(p.ws + O_RV); float* RY = (float*)(p.ws + O_RY);
    const bool loader = wave >= 4;
    const int lt = tid - 256;
    const int kq = lane & 15, rowl = wave * 4 + (lane >> 4), vrow = rq * 16 + rowl;
    float S0 = 0.f, S1 = 0.f, S2 = 0.f, S3 = 0.f;
    const int NB = sample ? 32 : 8;
    if (!loader && sample) { const float4 s = *(const float4*)(p.in[6] + ((size_t)((l * 32 + b) * 4 + h) * 64 + vrow) * 64 + kq * 4); S0 = s.x; S1 = s.y; S2 = s.z; S3 = s.w; }
    auto load_chunk = [&](int c) {
        const int buf = c & 1; const size_t t0 = rowg0 + (size_t)c * CT;
        float4 tmp[10]; float4 tv;
#pragma unroll
        for (int a = 0; a < 5; ++a)
#pragma unroll
            for (int i = 0; i < 2; ++i) { const int idx = lt + i * 256, r = idx >> 4, c4 = idx & 15; tmp[a * 2 + i] = (r < CT) ? *(const float4*)(arr[a] + (t0 + r) * 256 + h * 64 + c4 * 4) : make_float4(0.f, 0.f, 0.f, 0.f); }
        { const int r = lt >> 2, c4 = lt & 3; tv = (lt < 128 && r < CT) ? *(const float4*)(RV + (t0 + r) * 256 + h * 64 + rq * 16 + c4 * 4) : make_float4(0.f, 0.f, 0.f, 0.f); }
#pragma unroll
        for (int a = 0; a < 5; ++a)
#pragma unroll
            for (int i = 0; i < 2; ++i) { const int idx = lt + i * 256; *(float4*)(vec + ((size_t)(buf * 5 + a) * 32) * 64 + idx * 4) = tmp[a * 2 + i]; }
        if (lt < 128) *(float4*)(vb + buf * 512 + lt * 4) = tv;
    };
    auto flush_y = [&](int c) {
        const int buf = c & 1; const size_t t0 = rowg0 + (size_t)c * CT;
        if (lt < 128) { const int r = lt >> 2, c4 = lt & 3; if (r < CT) *(float4*)(RY + (t0 + r) * 256 + h * 64 + rq * 16 + c4 * 4) = *(const float4*)(yb + buf * 512 + lt * 4); }
    };
    if (loader) load_chunk(0);
    __syncthreads();
    for (int c = 0; c < nch; ++c) {
        if (loader) { if (c + 1 < nch) load_chunk(c + 1); if (c > 0) flush_y(c - 1); }
        else {
            const int buf = c & 1;
            const float4* v4 = (const float4*)(vec + (size_t)buf * 5 * 32 * 64);
            const float* vbb = vb + buf * 512; float* ybb = yb + buf * 512;
#pragma unroll 4
            for (int t = 0; t < CT; ++t) {
                const float4 a4 = v4[(0 * 32 + t) * 16 + kq], w4 = v4[(1 * 32 + t) * 16 + kq], k4 = v4[(2 * 32 + t) * 16 + kq], b4 = v4[(3 * 32 + t) * 16 + kq], r4 = v4[(4 * 32 + t) * 16 + kq];
                const float vv = vbb[t * 16 + rowl];
                float sa = S0 * a4.x + S1 * a4.y + S2 * a4.z + S3 * a4.w;
                sa = red16_sum(sa);
                S0 = S0 * w4.x + (sa * b4.x + vv * k4.x); S1 = S1 * w4.y + (sa * b4.y + vv * k4.y); S2 = S2 * w4.z + (sa * b4.z + vv * k4.z); S3 = S3 * w4.w + (sa * b4.w + vv * k4.w);
                float y = S0 * r4.x + S1 * r4.y + S2 * r4.z + S3 * r4.w;
                y = red16_sum(y);
                if (kq == 0) ybb[t * 16 + rowl] = y;
            }
        }
        __syncthreads();
    }
    if (loader) flush_y(nch - 1);
    else { float* so = p.out + (sample ? OUT_SRWKV : OUT_PRWKV) + ((size_t)((l * NB + b) * 4 + h) * 64 + vrow) * 64 + kq * 4; *(float4*)so = make_float4(S0, S1, S2, S3); }
    __syncthreads();
}

__device__ __forceinline__ void gla_item(const Ctx& p, int l, int sample, int b, int h, unsigned char* smem) {
    const int tid = launder_v(threadIdx.x), wave = tid >> 6, lane = tid & 63, fr = lane & 15, fq = lane >> 4;
    const int CL = sample ? 4 : 64, nch = sample ? 1 : 32, NB = sample ? 32 : 8;
    const size_t row_base = sample ? (size_t)(16384 + b * 4) : (size_t)b * 2048;
    bf16_t* qe = (bf16_t*)smem;
    bf16_t* ke = qe + 64 * 40;
    bf16_t* kdT = ke + 64 * 40;
    bf16_t* vT = kdT + 32 * 72;
    bf16_t* att = vT + 64 * 72;
    bf16_t* ST = att + 64 * 72;
    float* qf = (float*)(smem + 38400);
    float* kf = qf + 64 * 33;
    float* la = kf + 64 * 33;
    float* bc = la + 64 * 33;
    float* alr = bc + 64 * 33;
    float* w2s = alr + 64 * 17;
    float* bal = w2s + 512;
    float* dec = bal + 32;
    float* Sf = dec + 32;
    float* of = Sf + 2048;
    const bf16_t* COLS = (const bf16_t*)(p.ws + O_COLS);
    bf16_t* MIX = (bf16_t*)(p.ws + O_MIX);
    w2s[tid] = p.in[14][(size_t)l * 16 * 128 + (tid >> 5) * 128 + h * 32 + (tid & 31)];
    if (tid < 32) bal[tid] = p.in[15][l * 128 + h * 32 + tid];
    for (int i = tid; i < 2048; i += 512) Sf[i] = sample ? p.in[5][(size_t)((l * 32 + b) * 4 + h) * 2048 + i] : 0.f;
    __syncthreads();
    for (int c = 0; c < nch; ++c) {
        const size_t r0 = row_base + (size_t)c * CL;
        for (int i = tid; i < 2048; i += 512) { const int t = i >> 5, kk = i & 31; float qv = 0.f, kv = 0.f;
            if (t < CL) { const bf16_t* cp = COLS + (r0 + t) * NINP + C_GLA; qv = bf2f(cp[h * 32 + kk]); kv = bf2f(cp[128 + h * 32 + kk]); }
            qf[t * 33 + kk] = qv; kf[t * 33 + kk] = kv; }
        for (int i = tid; i < 4096; i += 512) { const int t = i >> 6, v = i & 63; bf16_t x = 0; if (t < CL) x = COLS[(r0 + t) * NINP + C_GLA + 256 + h * 64 + v]; vT[v * 72 + t] = x; }
        for (int i = tid; i < 1024; i += 512) { const int t = i >> 4, rr = i & 15; alr[t * 17 + rr] = t < CL ? bf2f(COLS[(r0 + t) * NINP + C_GLA + 512 + rr]) : 0.f; }
        __syncthreads();
        for (int i = tid; i < 2048; i += 512) { const int t = i >> 5, kk = i & 31; float x = bal[kk];
#pragma unroll
            for (int rr = 0; rr < 16; ++rr) x += alr[t * 17 + rr] * w2s[rr * 32 + kk];
            const float ls = fminf(x, 0.f) - log1pf(__expf(-fabsf(x)));
            la[t * 33 + kk] = t < CL ? ls * (1.f / 16.f) : 0.f; }
        __syncthreads();
        for (int i = tid; i < 2048; i += 512) { const int t = i >> 5, kk = i & 31; float s = 0.f; for (int s_ = 0; s_ <= t; ++s_) s += la[s_ * 33 + kk]; bc[t * 33 + kk] = s; }
        __syncthreads();
        for (int i = tid; i < 2048; i += 512) { const int t = i >> 5, kk = i & 31; const float bb = bc[t * 33 + kk], bl = bc[(CL - 1) * 33 + kk], q = qf[t * 33 + kk], k = kf[t * 33 + kk];
            qe[t * 40 + kk] = f2bf(q * __expf(bb) * 0.17677669529663687f); ke[t * 40 + kk] = f2bf(k * __expf(-bb)); kdT[kk * 72 + t] = t < CL ? f2bf(k * __expf(bl - bb)) : (bf16_t)0; }
        if (tid < 32) dec[tid] = __expf(bc[(CL - 1) * 33 + tid]);
        for (int i = tid; i < 2048; i += 512) { const int kk = i >> 6, v = i & 63; ST[v * 40 + kk] = f2bf(Sf[i]); }
        __syncthreads();
        for (int ti = wave * 2; ti < wave * 2 + 2; ++ti) {
            const int tt = ti >> 2, st = ti & 3; f32x4 acc = {0.f, 0.f, 0.f, 0.f};
            if (st <= tt) acc = mma16(ldfrag(qe, 40, tt * 16, 0, lane), ldfrag(ke, 40, st * 16, 0, lane), acc);
#pragma unroll
            for (int j = 0; j < 4; ++j) { const int t = tt * 16 + fq * 4 + j, s = st * 16 + fr; att[t * 72 + s] = f2bf(s <= t ? acc[j] : 0.f); }
        }
        __syncthreads();
        for (int ti = wave * 2; ti < wave * 2 + 2; ++ti) {
            const int tt = ti >> 2, vt = ti & 3; f32x4 acc = {0.f, 0.f, 0.f, 0.f};
#pragma unroll
            for (int ks = 0; ks < 2; ++ks) acc = mma16(ldfrag(att, 72, tt * 16, ks * 32, lane), ldfrag(vT, 72, vt * 16, ks * 32, lane), acc);
            acc = mma16(ldfrag(qe, 40, tt * 16, 0, lane), ldfrag(ST, 40, vt * 16, 0, lane), acc);
#pragma unroll
            for (int j = 0; j < 4; ++j) of[(tt * 16 + fq * 4 + j) * 65 + vt * 16 + fr] = acc[j];
        }
        { const int kt = wave >> 2, vt = wave & 3; f32x4 acc = {0.f, 0.f, 0.f, 0.f};
#pragma unroll
            for (int ks = 0; ks < 2; ++ks) acc = mma16(ldfrag(kdT, 72, kt * 16, ks * 32, lane), ldfrag(vT, 72, vt * 16, ks * 32, lane), acc);
#pragma unroll
            for (int j = 0; j < 4; ++j) { const int kk = kt * 16 + fq * 4 + j, v = vt * 16 + fr; Sf[kk * 64 + v] = dec[kk] * Sf[kk * 64 + v] + acc[j]; } }
        __syncthreads();
        { const int t = tid >> 3, part = tid & 7; float ov[8]; float ss = 0.f;
#pragma unroll
            for (int i = 0; i < 8; ++i) { ov[i] = of[t * 65 + part * 8 + i]; ss += ov[i] * ov[i]; }
            ss = red8_sum(ss);
            const float rs = rsqrtf(ss * (1.f / 64.f) + EPS);
            if (t < CL) { const bf16_t* gp = COLS + (r0 + t) * NINP + C_GLA + 528 + h * 64 + part * 8; const float* gn = p.in[16] + l * 256 + h * 64 + part * 8;
                float o[8];
#pragma unroll
                for (int i = 0; i < 8; ++i) o[i] = ov[i] * rs * gn[i] * silu_f(bf2f(gp[i]));
                uint4 w; w.x = pack2(o[0], o[1]); w.y = pack2(o[2], o[3]); w.z = pack2(o[4], o[5]); w.w = pack2(o[6], o[7]);
                *(uint4*)(MIX + (r0 + t) * 1024 + h * 64 + part * 8) = w; } }
        __syncthreads();
    }
    float* so = p.out + (sample ? OUT_SGLA : OUT_PGLA) + (size_t)((l * NB + b) * 4 + h) * 2048;
    for (int i = tid; i < 2048; i += 512) so[i] = Sf[i];
    __syncthreads();
}

__device__ __forceinline__ void gmlp_prompt_item(const Ctx& p, int l, int id, unsigned char* smem) {
    const int tid = launder_v(threadIdx.x), wave = tid >> 6, lane = tid & 63, fr = lane & 15, fq = lane >> 4;
    const size_t r0 = (size_t)(id >> 4) * 2048 + (size_t)(id & 15) * 128;
    bf16_t* vnT = (bf16_t*)smem;
    bf16_t* Wb = vnT + 256 * 136;
    const bf16_t* COLS = (const bf16_t*)(p.ws + O_COLS);
    bf16_t* MIX = (bf16_t*)(p.ws + O_MIX);
    for (int hf = 0; hf < 4; ++hf) { const int t = hf * 32 + (tid >> 4), part = tid & 15;
        const uint4* src = (const uint4*)(COLS + (r0 + t) * NINP + C_GMLP + 256 + part * 16);
        float x[16]; float s = 0.f;
#pragma unroll
        for (int i = 0; i < 2; ++i) { const uint4 w = src[i]; const unsigned ww[4] = {w.x, w.y, w.z, w.w};
#pragma unroll
            for (int k = 0; k < 4; ++k) { x[i * 8 + k * 2] = gelu_e(__uint_as_float(ww[k] << 16)); x[i * 8 + k * 2 + 1] = gelu_e(__uint_as_float(ww[k] & 0xffff0000u)); } }
#pragma unroll
        for (int i = 0; i < 16; ++i) s += x[i];
        s = red16_sum(s);
        const float mean = s * (1.f / 256.f); float q = 0.f;
#pragma unroll
        for (int i = 0; i < 16; ++i) { const float d = x[i] - mean; q += d * d; }
        q = red16_sum(q);
        const float rstd = rsqrtf(q * (1.f / 256.f) + 1e-5f);
        const float* lg = p.in[17] + l * 256 + part * 16; const float* lb = p.in[18] + l * 256 + part * 16;
#pragma unroll
        for (int i = 0; i < 16; ++i) vnT[(part * 16 + i) * 136 + t] = f2bf((x[i] - mean) * rstd * lg[i] + lb[i]);
    }
    for (int g = 0; g < 4; ++g) {
        const float* W = p.in[19] + (size_t)(l * 4 + g) * 128 * 128;
        for (int i = 0; i < 32; ++i) { const int idx = tid + i * 512, t = idx >> 7, s = idx & 127; Wb[t * 136 + s] = s <= t ? f2bf(W[idx]) : (bf16_t)0; }
        __syncthreads();
        const int tt = wave; f32x4 acc[4];
#pragma unroll
        for (int ct = 0; ct < 4; ++ct) acc[ct] = (f32x4){0.f, 0.f, 0.f, 0.f};
#pragma unroll
        for (int ks = 0; ks < 4; ++ks) { const bf16x8 a = ldfrag(Wb, 136, tt * 16, ks * 32, lane);
#pragma unroll
            for (int ct = 0; ct < 4; ++ct) acc[ct] = mma16(a, ldfrag(vnT, 136, g * 64 + ct * 16, ks * 32, lane), acc[ct]); }
        const float* bs = p.in[20] + (size_t)(l * 4 + g) * 128;
#pragma unroll
        for (int j = 0; j < 4; ++j) { const int t = tt * 16 + fq * 4 + j; const float bsv = bs[t];
#pragma unroll
            for (int ct = 0; ct < 4; ++ct) { const int c = g * 64 + ct * 16 + fr; const float u = gelu_e(bf2f(COLS[(r0 + t) * NINP + C_GMLP + c])); MIX[(r0 + t) * 1024 + 256 + c] = f2bf(u * (acc[ct][j] + bsv)); } }
        __syncthreads();
    }
}

__device__ __forceinline__ void gmlp_sample_item(const Ctx& p, int l, int b, unsigned char* smem) {
    const int tid = launder_v(threadIdx.x), wave = tid >> 6, lane = tid & 63;
    const size_t r0 = (size_t)(16384 + b * 4);
    float* vv = (float*)smem;
    const bf16_t* COLS = (const bf16_t*)(p.ws + O_COLS);
    bf16_t* MIX = (bf16_t*)(p.ws + O_MIX);
    for (int e = tid; e < 1024; e += 512) { const int t = e >> 8, c = e & 255; vv[e] = gelu_e(bf2f(COLS[(r0 + t) * NINP + C_GMLP + 256 + c])); }
    __syncthreads();
    if (wave < 4) { const int t = wave; float x[4]; float s = 0.f;
#pragma unroll
        for (int i = 0; i < 4; ++i) { x[i] = vv[t * 256 + lane + 64 * i]; s += x[i]; }
        s = wave_sum(s); const float mean = s * (1.f / 256.f); float q = 0.f;
#pragma unroll
        for (int i = 0; i < 4; ++i) { const float d = x[i] - mean; q += d * d; }
        q = wave_sum(q); const float rstd = rsqrtf(q * (1.f / 256.f) + 1e-5f);
#pragma unroll
        for (int i = 0; i < 4; ++i) { const int c = lane + 64 * i; const float vn = (x[i] - mean) * rstd * p.in[17][l * 256 + c] + p.in[18][l * 256 + c]; vv[t * 256 + c] = vn;
            p.out[OUT_SGV + ((size_t)(l * 32 + b) * 4 + t) * 256 + c] = vn; } }
    __syncthreads();
    for (int e = tid; e < 1024; e += 512) { const int t = e >> 8, c = e & 255, g = c >> 6;
        const float* W = p.in[19] + (size_t)(l * 4 + g) * 128 * 128 + t * 128;
        float s = p.in[20][(size_t)(l * 4 + g) * 128 + t];
        for (int s_ = 0; s_ <= t; ++s_) s += W[s_] * vv[s_ * 256 + c];
        const float u = gelu_e(bf2f(COLS[(r0 + t) * NINP + C_GMLP + c]));
        MIX[(r0 + t) * 1024 + 256 + c] = f2bf(u * s); }
    __syncthreads();
}

__device__ __forceinline__ void dil_prompt_item(const Ctx& p, int l, int id, unsigned char* smem) {
    const int tid = launder_v(threadIdx.x), wave = tid >> 6, lane = tid & 63, fr = lane & 15, fq = lane >> 4;
    const int h = id & 3, qb = (id >> 2) & 15, gi = (id >> 6) % 3, b = id / 192;
    const int dsh = gi * 2, d = 1 << dsh, nbk = 16 >> dsh, r = qb / nbk, mb = qb % nbk;
    const bf16_t* cols = (const bf16_t*)(p.ws + O_COLS) + (size_t)(b * 2048) * NINP + C_DIL + gi * 768 + h * 64;
    bf16_t* Ks = (bf16_t*)smem;
    bf16_t* Qs = Ks + 256 * 72;
    bf16_t* Vt = Qs + 128 * 72;
    bf16_t* Pw = (bf16_t*)smem + wave * 16 * 168;
    bf16_t* DILO = (bf16_t*)(p.ws + O_DILO); float* LSE = (float*)(p.ws + O_LSE);
    { const int row = tid >> 1, half = tid & 1, mk = mb * 128 - 128 + row;
        uint4 v0 = make_uint4(0, 0, 0, 0), v1 = v0, v2 = v0, v3 = v0;
        if (mk >= 0) { const uint4* s = (const uint4*)(cols + (size_t)(r + d * mk) * NINP + 256 + half * 32); v0 = s[0]; v1 = s[1]; v2 = s[2]; v3 = s[3]; }
        uint4* dp = (uint4*)(Ks + row * 72 + half * 32); dp[0] = v0; dp[1] = v1; dp[2] = v2; dp[3] = v3; }
    { const int key = tid & 255, dh = tid >> 8, mk = mb * 128 - 128 + key;
        uint4 v[4]; v[0] = make_uint4(0, 0, 0, 0); v[1] = v[0]; v[2] = v[0]; v[3] = v[0];
        if (mk >= 0) { const uint4* s = (const uint4*)(cols + (size_t)(r + d * mk) * NINP + 512 + dh * 32); v[0] = s[0]; v[1] = s[1]; v[2] = s[2]; v[3] = s[3]; }
#pragma unroll
        for (int i = 0; i < 4; ++i) { const unsigned ww[4] = {v[i].x, v[i].y, v[i].z, v[i].w};
#pragma unroll
            for (int k = 0; k < 4; ++k) { Vt[(dh * 32 + i * 8 + k * 2) * 280 + key] = (bf16_t)(ww[k] & 0xffffu); Vt[(dh * 32 + i * 8 + k * 2 + 1) * 280 + key] = (bf16_t)(ww[k] >> 16); } } }
    for (int idx = tid; idx < 64 * 24; idx += 512) Vt[(idx / 24) * 280 + 256 + idx % 24] = 0;
    { const int row = tid >> 2, qt = tid & 3, m = mb * 128 + row;
        const uint4* s = (const uint4*)(cols + (size_t)(r + d * m) * NINP + qt * 16);
        uint4* dp = (uint4*)(Qs + row * 72 + qt * 16); dp[0] = s[0]; dp[1] = s[1]; }
    __syncthreads();
    const int q0 = wave * 16, kx0 = wave * 16;
    f32x4 acc[9];
    { const bf16x8 a0 = ldfrag(Qs, 72, q0, 0, lane), a1 = ldfrag(Qs, 72, q0, 32, lane);
#pragma unroll
        for (int t = 0; t < 9; ++t) { acc[t] = (f32x4){0.f, 0.f, 0.f, 0.f};
            acc[t] = mma16(a0, ldfrag(Ks, 72, kx0 + t * 16, 0, lane), acc[t]); acc[t] = mma16(a1, ldfrag(Ks, 72, kx0 + t * 16, 32, lane), acc[t]); } }
    const float slope = exp2f(-8.f * (float)(gi * 4 + h + 1) / 12.f) * (float)d;
    float mx[4] = {-1e30f, -1e30f, -1e30f, -1e30f}, den[4] = {0.f, 0.f, 0.f, 0.f};
#pragma unroll
    for (int t = 0; t < 9; ++t)
#pragma unroll
        for (int j = 0; j < 4; ++j) { const int qi = q0 + fq * 4 + j, kx = kx0 + t * 16 + fr, dist = qi + 128 - kx;
            const bool valid = dist >= 0 && dist <= 128 && (mb * 128 - 128 + kx) >= 0;
            const float s = valid ? acc[t][j] * 0.125f - slope * (float)dist : -1e30f; acc[t][j] = s; mx[j] = fmaxf(mx[j], s); }
#pragma unroll
    for (int j = 0; j < 4; ++j) mx[j] = red16_max(mx[j]);
#pragma unroll
    for (int t = 0; t < 9; ++t)
#pragma unroll
        for (int j = 0; j < 4; ++j) { const float pv = acc[t][j] > -1e29f ? __expf(acc[t][j] - mx[j]) : 0.f; acc[t][j] = pv; den[j] += pv; }
#pragma unroll
    for (int j = 0; j < 4; ++j) den[j] = red16_sum(den[j]);
    __syncthreads();
#pragma unroll
    for (int t = 0; t < 9; ++t)
#pragma unroll
        for (int j = 0; j < 4; ++j) Pw[(fq * 4 + j) * 168 + t * 16 + fr] = f2bf(acc[t][j]);
    for (int i = lane; i < 16 * 24; i += 64) Pw[(i / 24) * 168 + 144 + i % 24] = 0;
    __syncthreads();
    f32x4 o[4];
#pragma unroll
    for (int dt = 0; dt < 4; ++dt) o[dt] = (f32x4){0.f, 0.f, 0.f, 0.f};
#pragma unroll
    for (int kk = 0; kk < 5; ++kk) { const bf16x8 pa = *(const bf16x8*)(Pw + fr * 168 + kk * 32 + fq * 8);
#pragma unroll
        for (int dt = 0; dt < 4; ++dt) { const bf16x8 vb = *(const bf16x8*)(Vt + (dt * 16 + fr) * 280 + kx0 + kk * 32 + fq * 8); o[dt] = mma16(pa, vb, o[dt]); } }
#pragma unroll
    for (int j = 0; j < 4; ++j) { const int qi = q0 + fq * 4 + j, m = mb * 128 + qi; const size_t rowg = (size_t)b * 2048 + r + d * m; const float inv = 1.f / den[j];
#pragma unroll
        for (int dt = 0; dt < 4; ++dt) DILO[((size_t)gi * MR + rowg) * 256 + h * 64 + dt * 16 + fr] = f2bf(o[dt][j] * inv);
        if (fr == 0) LSE[((size_t)gi * MR + rowg) * 4 + h] = mx[j] + __logf(den[j]); }
    __syncthreads();
}

__device__ __forceinline__ void dil_sample_item(const Ctx& p, int l, int b, unsigned char* smem) {
    const int tid = launder_v(threadIdx.x), wave = tid >> 6, lane = tid & 63;
    const size_t r0 = (size_t)(16384 + b * 4);
    float* qs = (float*)smem;
    float* sc = qs + 4 * 768;
    float* mden = sc + 48 * 132;
    const bf16_t* COLS = (const bf16_t*)(p.ws + O_COLS);
    bf16_t* DILO = (bf16_t*)(p.ws + O_DILO); float* LSE = (float*)(p.ws + O_LSE);
    for (int e = tid; e < 4 * 768; e += 512) { const int i = e / 768, c = e % 768, gi = c >> 8, hc = c & 255; qs[e] = bf2f(COLS[(r0 + i) * NINP + C_DIL + gi * 768 + hc]); }
    __syncthreads();
    for (int idx = tid; idx < 48 * 129; idx += 512) {
        const int combo = idx / 129, j = idx % 129, i = combo / 12, gi = (combo >> 2) % 3, h = combo & 3;
        const int d = 1 << (gi * 2), L = gi == 0 ? 128 : (gi == 1 ? 512 : 2048), off = j * d, rel = i - off;
        const float* q = qs + i * 768 + gi * 256 + h * 64;
        float dot = 0.f;
        if (rel >= 0) { const bf16_t* kp = COLS + (r0 + rel) * NINP + C_DIL + gi * 768 + 256 + h * 64;
            for (int dd = 0; dd < 64; ++dd) dot += q[dd] * bf2f(kp[dd]); }
        else { const float* cache = p.in[2 + gi]; const float4* kp = (const float4*)(cache + ((((size_t)(l * 32 + b) * L + (L + rel)) * 2 + 0) * 4 + h) * 64);
            for (int dd = 0; dd < 16; ++dd) { const float4 kv = kp[dd]; dot += q[dd * 4] * kv.x + q[dd * 4 + 1] * kv.y + q[dd * 4 + 2] * kv.z + q[dd * 4 + 3] * kv.w; } }
        const float slope = exp2f(-8.f * (float)(gi * 4 + h + 1) / 12.f);
        sc[combo * 132 + j] = dot * 0.125f - slope * (float)off;
    }
    __syncthreads();
    for (int combo = wave; combo < 48; combo += 8) {
        float s0 = sc[combo * 132 + lane], s1 = sc[combo * 132 + 64 + lane], s2 = lane == 0 ? sc[combo * 132 + 128] : -1e30f;
        const float m = wave_max(fmaxf(fmaxf(s0, s1), s2));
        const float p0 = __expf(s0 - m), p1 = __expf(s1 - m), p2 = lane == 0 ? __expf(s2 - m) : 0.f;
        const float dn = wave_sum(p0 + p1 + p2);
        sc[combo * 132 + lane] = p0; sc[combo * 132 + 64 + lane] = p1; if (lane == 0) { sc[combo * 132 + 128] = p2; mden[combo * 2] = m; mden[combo * 2 + 1] = dn; }
    }
    __syncthreads();
    for (int idx = tid; idx < 48 * 64; idx += 512) {
        const int combo = idx >> 6, dd = idx & 63, i = combo / 12, gi = (combo >> 2) % 3, h = combo & 3;
        const int d = 1 << (gi * 2), L = gi == 0 ? 128 : (gi == 1 ? 512 : 2048);
        const float* cache = p.in[2 + gi];
        float acc = 0.f;
        for (int j = 0; j < 129; ++j) { const int rel = i - j * d; float v;
            if (rel >= 0) v = bf2f(COLS[(r0 + rel) * NINP + C_DIL + gi * 768 + 512 + h * 64 + dd]);
            else v = cache[((((size_t)(l * 32 + b) * L + (L + rel)) * 2 + 1) * 4 + h) * 64 + dd];
            acc += sc[combo * 132 + j] * v; }
        const float dn = mden[combo * 2 + 1];
        DILO[((size_t)gi * MR + r0 + i) * 256 + h * 64 + dd] = f2bf(acc / dn);
        if (dd == 0) LSE[((size_t)gi * MR + r0 + i) * 4 + h] = mden[combo * 2] + __logf(dn);
    }
    __syncthreads();
}

__device__ __forceinline__ void phase_mixer_main(const Ctx& p0, int l0, unsigned char* smem) {
    unsigned* ctr = (unsigned*)(p0.ws + O_CTR) + l0;
    __shared__ int s_item;
    for (;;) {
        if (threadIdx.x == 0) s_item = (int)atomicAdd(ctr, 1u);
        __syncthreads();
        const int it = s_item;
        __syncthreads();
        if (it >= 2528) break;
        const Ctx p{p0.in, launder_p(p0.out), launder_p(p0.ws)}; const int l = launder_s(l0);
        if (it < 128) rwkv_item(p, l, 0, it >> 4, (it >> 2) & 3, it & 3, smem);
        else if (it < 160) { const int u = it - 128; gla_item(p, l, 0, u >> 2, u & 3, smem); }
        else if (it < 192) dil_sample_item(p, l, it - 160, smem);
        else if (it < 1728) dil_prompt_item(p, l, it - 192, smem);
        else if (it < 1856) gmlp_prompt_item(p, l, it - 1728, smem);
        else if (it < 2368) { const int u = it - 1856; rwkv_item(p, l, 1, u >> 4, (u >> 2) & 3, u & 3, smem); }
        else if (it < 2496) { const int u = it - 2368; gla_item(p, l, 1, u >> 2, u & 3, smem); }
        else gmlp_sample_item(p, l, it - 2496, smem);
    }
}

__device__ __forceinline__ void phase_mixer_post(const Ctx& p, int l) {
    const int tid = launder_v(threadIdx.x), wave = tid >> 6, lane = tid & 63;
    const float* RY = (const float*)(p.ws + O_RY); const float* RV = (const float*)(p.ws + O_RV); const float* RG = (const float*)(p.ws + O_RG); const float* BON = (const float*)(p.ws + O_BON);
    const bf16_t* DILO = (const bf16_t*)(p.ws + O_DILO); const float* LSE = (const float*)(p.ws + O_LSE);
    bf16_t* MIX = (bf16_t*)(p.ws + O_MIX);
    const float* lg = p.in[30] + l * 256; const float* lb = p.in[31] + l * 256;
    for (int row = blockIdx.x * 8 + wave; row < MR; row += gridDim.x * 8) {
#pragma unroll
        for (int hh = 0; hh < 4; ++hh) {
            const int ch = hh * 64 + lane;
            const float y = RY[(size_t)row * 256 + ch];
            const float mean = wave_sum(y) * (1.f / 64.f);
            const float dv = y - mean;
            const float var = wave_sum(dv * dv) * (1.f / 64.f);
            const float yn = dv * rsqrtf(var + 64e-5f) * lg[ch] + lb[ch];
            const float o = (yn + BON[(size_t)row * 4 + hh] * RV[(size_t)row * 256 + ch]) * RG[(size_t)row * 256 + ch];
            MIX[(size_t)row * 1024 + 512 + ch] = f2bf(o);
            const float l0 = LSE[((size_t)0 * MR + row) * 4 + hh], l1 = LSE[((size_t)1 * MR + row) * 4 + hh], l2 = LSE[((size_t)2 * MR + row) * 4 + hh];
            const float mx = fmaxf(l0, fmaxf(l1, l2));
            const float e0 = __expf(l0 - mx), e1 = __expf(l1 - mx), e2 = __expf(l2 - mx), inv = 1.f / (e0 + e1 + e2);
            const float od = (e0 * bf2f(DILO[((size_t)0 * MR + row) * 256 + ch]) + e1 * bf2f(DILO[((size_t)1 * MR + row) * 256 + ch]) + e2 * bf2f(DILO[((size_t)2 * MR + row) * 256 + ch])) * inv;
            MIX[(size_t)row * 1024 + 768 + ch] = f2bf(od);
        }
    }
}

__global__ __launch_bounds__(512, 2) void mega(Params pk) {
    extern __shared__ __attribute__((aligned(16))) unsigned char smem[];
    __shared__ const float* s_in[32];
    cg::grid_group grid = cg::this_grid();
    if (threadIdx.x == 0) {
#pragma unroll
        for (int i = 0; i < 32; ++i) s_in[i] = pk.in[i];
    }
    __syncthreads();
    for (int si = pk.ph_lo; si < pk.ph_hi; ++si) {
        const Ctx p{s_in, launder_p(pk.out), launder_p(pk.ws)};
        if (si < 0) phase_prologue(p, smem);
        else {
            const int l = si / 12, j = si % 12;
            if (j == 0 || j == 9) {
                const int blk = l * 2 + (j == 9);
                pg8::Gemm g{(const bf16_t*)(p.ws + O_XN), (const bf16_t*)(p.ws + O_WGU + blk * SZ_WGU1), MPAD, 5632, 1024};
                pg8::StaticOrder S; S.init(g.M, g.N, (int)gridDim.x, (int)blockIdx.x);
                EpiSwiGLU E{(bf16_t*)(p.ws + O_ACT)};
                pg8::gemm_phase<EpiSwiGLU, pg8::StaticOrder, false>((PG8_LAS unsigned char*)smem, g, S, E, nullptr);
            } else if (j == 1 || j == 10 || j == 7) {
                const bf16_t* A; const bf16_t* Bt; int K;
                if (j == 7) { A = (const bf16_t*)(p.ws + O_MIX); Bt = (const bf16_t*)(p.ws + O_WOUT + l * SZ_WOUT1); K = 1024; }
                else { A = (const bf16_t*)(p.ws + O_ACT); Bt = (const bf16_t*)(p.ws + O_WD + (l * 2 + (j == 10)) * SZ_WD1); K = 2816; }
                pg8::Gemm g{A, Bt, 16384, 1024, K};
                pg8::StaticOrder S; S.init(g.M, g.N, (int)gridDim.x, (int)blockIdx.x);
                EpiF32SS E{(float*)(p.ws + O_F), (float*)(p.ws + O_SSP)};
                pg8::gemm_phase<EpiF32SS, pg8::StaticOrder, false>((PG8_LAS unsigned char*)smem, g, S, E, nullptr);
                __syncthreads();
                tail_gemm(A, Bt, K, (float*)(p.ws + O_F), (float*)(p.ws + O_SSPT), smem);
            } else if (j == 2 || j == 8 || j == 11) {
                phase_ew(p, l, j == 2 ? 0 : (j == 8 ? 1 : 2));
            } else if (j == 3) {
                pg8::Gemm g{(const bf16_t*)(p.ws + O_XN), (const bf16_t*)(p.ws + O_WIN + l * SZ_WIN1), MPAD, NINP, 1024};
                pg8::StaticOrder S; S.init(g.M, g.N, (int)gridDim.x, (int)blockIdx.x);
                EpiBf16P E{(bf16_t*)(p.ws + O_COLS), NINP};
                pg8::gemm_phase<EpiBf16P, pg8::StaticOrder, false>((PG8_LAS unsigned char*)smem, g, S, E, nullptr);
            } else if (j == 4) phase_mixer_pre(p, l, smem);
            else if (j == 5) phase_mixer_main(p, l, smem);
            else phase_mixer_post(p, l);
        }
        if (si + 1 < pk.ph_hi) grid.sync();
    }
}

#ifndef MK_LAUNCH_PER_PHASE
#define MK_LAUNCH_PER_PHASE 0
#endif
extern "C" void kernel_launch(void* const* d_in, const int* in_sizes, int n_in, void* d_out, int out_size, void* d_ws, size_t ws_size, hipStream_t stream) {
    static int grid = 0;
    if (grid == 0) {
        if (n_in != 32 || (size_t)out_size != OUT_END || ws_size < WS_END) { fprintf(stderr, "kernel_launch: unexpected shapes: n_in %d out %d ws %zu (need %zu)\n", n_in, out_size, ws_size, (size_t)WS_END); grid = -1; return; }
        int dev = 0, cus = 0, per_cu = 0;
        hipGetDevice(&dev); hipDeviceGetAttribute(&cus, hipDeviceAttributeMultiprocessorCount, dev);
        if (hipFuncSetAttribute((const void*)mega, hipFuncAttributeMaxDynamicSharedMemorySize, LDS_BYTES) != hipSuccess) { fprintf(stderr, "kernel_launch: hipFuncSetAttribute failed\n"); grid = -1; return; }
        if (hipOccupancyMaxActiveBlocksPerMultiprocessor(&per_cu, (const void*)mega, 512, LDS_BYTES) != hipSuccess || per_cu < 1) { fprintf(stderr, "kernel_launch: occupancy query says %d\n", per_cu); per_cu = 1; }
        (void)hipGetLastError();
        grid = cus * 1;
    }
    if (grid < 0) return;
    Params p{};
    for (int i = 0; i < 32; ++i) p.in[i] = (const float*)d_in[i];
    p.out = (float*)d_out; p.ws = (unsigned char*)d_ws;
#if MK_LAUNCH_PER_PHASE
    for (int si = -1; si < 24; ++si) { p.ph_lo = si; p.ph_hi = si + 1; hipLaunchKernelGGL(mega, dim3(grid), dim3(512), LDS_BYTES, stream, p); }
#else
    p.ph_lo = -1; p.ph_hi = 24;
    void* args[] = {&p};
    hipError_t e = hipLaunchCooperativeKernel((const void*)mega, dim3(grid), dim3(512), args, LDS_BYTES, stream);
    if (e != hipSuccess) fprintf(stderr, "cooperative launch failed: %s (grid %d)\n", hipGetErrorString(e), grid);
#endif
}
```

```cpp
#include <hip/hip_runtime.h>
#include <hip/hip_cooperative_groups.h>
#include <cstdio>
namespace cg = cooperative_groups;
__device__ __forceinline__ int launder_v(int x) { asm volatile("" : "+v"(x)); return x; }
__device__ __forceinline__ int launder_s(int x) { asm volatile("" : "+s"(x)); return x; }
#define GAS __attribute__((address_space(1)))
typedef const GAS float* gfptr_t;
template <class T> __device__ __forceinline__ T* launder_p(T* p) {
#if defined(__HIP_DEVICE_COMPILE__)
    GAS T* g = (GAS T*)p; asm volatile("" : "+s"(g)); return (T*)g;
#else
    return p;
#endif
}
#define XB_TMO      128
#define XB_XCNT(j)  (256  + 64 * (j))
#define XB_XSUB(j)  (1280 + 64 * (j))
#define XB_XGEN(j)  (2304 + 64 * (j))
#define XB_TOP      3328
#define XB_TOPGEN   3392
#define XCD_BAR_WORDS 3456
#define XB_SPIN_CAP (1u << 18)
#define LAS __attribute__((address_space(3)))

__device__ __forceinline__ unsigned xb_ld(unsigned* p)              { return __hip_atomic_load(p, __ATOMIC_RELAXED, __HIP_MEMORY_SCOPE_AGENT); }
__device__ __forceinline__ unsigned xb_add(unsigned* p, unsigned v) { return __hip_atomic_fetch_add(p, v, __ATOMIC_RELAXED, __HIP_MEMORY_SCOPE_AGENT); }
__device__ __forceinline__ unsigned xb_xcc_id() { return (unsigned)__builtin_amdgcn_s_getreg((3 << 11) | 20) & 0xFu; }
#define XB_SPIN(cond, bar) do { unsigned _sp = 0; while (cond) { __builtin_amdgcn_s_sleep(1); \
    if ((++_sp & 255u) == 0u) { if (xb_ld(&(bar)[XB_TMO])) break; if (_sp > XB_SPIN_CAP) { atomicAdd(&(bar)[XB_TMO], 1u); break; } } } } while (0)

struct XcdBarrier {
    unsigned* bar; unsigned x;
    volatile LAS unsigned* st;
};

__device__ __forceinline__ XcdBarrier xcd_barrier_post(unsigned* bar, volatile LAS unsigned* st) {
    XcdBarrier b; b.bar = bar; b.x = xb_xcc_id(); b.st = st;
    if (threadIdx.x == 0) (void)xb_add(&bar[XB_XCNT(b.x)], 1u);
    return b;
}
__device__ __forceinline__ void xcd_barrier_complete(unsigned* bar, unsigned x, unsigned& nloc, unsigned& nx) {
    const unsigned G = gridDim.x * gridDim.y * gridDim.z;
    unsigned sum, cnt, mine, sp = 0u;
    for (;;) {
        sum = 0u; cnt = 0u; mine = 0u;
#pragma unroll
        for (unsigned j = 0; j < 16; ++j) { const unsigned c = xb_ld(&bar[XB_XCNT(j)]); sum += c; cnt += (c > 0u) ? 1u : 0u; mine = (j == x) ? c : mine; }
        if (sum == G) break;
        __builtin_amdgcn_s_sleep(1);
        if ((++sp & 255u) == 0u) { if (xb_ld(&bar[XB_TMO])) break; if (sp > XB_SPIN_CAP) { atomicAdd(&bar[XB_TMO], 1u); break; } }
    }
    nloc = mine > 0u ? mine : 1u; nx = cnt > 0u ? cnt : 1u;
}

__device__ __forceinline__ void xcd_barrier(const XcdBarrier& b) {
    asm volatile("s_waitcnt vmcnt(0)" ::: "memory");
    __syncthreads();
    if (threadIdx.x == 0) {
        unsigned* bar = b.bar;
        __builtin_amdgcn_s_waitcnt(0);
        unsigned nloc = b.st[0], nx = b.st[1];
        if (nloc == 0u) { xcd_barrier_complete(bar, b.x, nloc, nx); b.st[0] = nloc; b.st[1] = nx; }
        const unsigned old = xb_add(&bar[XB_XSUB(b.x)], 1u);
        const unsigned gen = old / nloc;
        if (old + 1u == (gen + 1u) * nloc) {
            __builtin_amdgcn_fence(__ATOMIC_RELEASE, "agent");
            asm volatile("s_waitcnt vmcnt(0)" ::: "memory");
            const unsigned og = xb_add(&bar[XB_TOP], 1u);
            const unsigned tg = og / nx;
            if (og + 1u == (tg + 1u) * nx) xb_add(&bar[XB_TOPGEN], 1u);
            else XB_SPIN(xb_ld(&bar[XB_TOPGEN]) == tg, bar);
            __builtin_amdgcn_fence(__ATOMIC_ACQUIRE, "agent");
            xb_add(&bar[XB_XGEN(b.x)], 1u);
            asm volatile("s_waitcnt vmcnt(0)" ::: "memory");
        } else {
            XB_SPIN(xb_ld(&bar[XB_XGEN(b.x)]) == gen, bar);
            __builtin_amdgcn_fence(__ATOMIC_ACQUIRE, "agent");
            asm volatile("s_waitcnt vmcnt(0)" ::: "memory");
        }
    }
    __syncthreads();
}
namespace pg8 {
#define PG8_LAS __attribute__((address_space(3)))
typedef unsigned short bf16_t;
typedef short bf16x8 __attribute__((ext_vector_type(8)));
typedef float f32x4 __attribute__((ext_vector_type(4)));
typedef unsigned u32x4 __attribute__((ext_vector_type(4)));
constexpr int BM = 256, BK = 64, HALF = 128, HTB = HALF * BK * 2  , STAGE_BYTES = 8 * HTB, NXCD = 8, WGM = 8;

__host__ __device__ __forceinline__ int lds_byte(int r, int c) { const int st = (r >> 4) * 2 + (c >> 5), rr = r & 15, cc = c & 31, ob = rr * 64 + cc * 2; return st * 1024 + (ob ^ (((ob >> 9) & 1) << 5)); }
__host__ __device__ __forceinline__ void stage_rc(int b, int& R, int& C) { const int st = b / 1024, sb = b % 1024, swz = sb ^ (((sb >> 9) & 1) << 5); R = (st >> 1) * 16 + swz / 64; C = (st & 1) * 32 + (swz % 64) / 2; }
__host__ __device__ __forceinline__ int perm32(int rho) { const int n = rho >> 4, i = rho & 15; return 8 * (i >> 2) + 4 * n + (i & 3); }

struct Unit { int pm, pn; };
struct Gemm { const bf16_t* A; const bf16_t* Bt; int M, N, K; };

struct StaticOrder {
    int nM, nN, nwg, G, c;
    __host__ __device__ void init(int M, int N, int G_, int c_) { nM = M / BM; nN = N / BM; nwg = nM * nN; G = G_; c = c_; }
    __host__ __device__ bool next(int i, Unit& u) const {
        const long L = (long)i * G + c; if (L >= nwg) return false;
        int wgid = (int)L; { const int q = nwg / NXCD, r = nwg % NXCD, xcd = wgid % NXCD, off = wgid / NXCD; wgid = (xcd < r ? xcd * (q + 1) : r * (q + 1) + (xcd - r) * q) + off; }
        const int nig = WGM * nN, gid = wgid / nig, fm = gid * WGM, gsz = (nM - fm) < WGM ? (nM - fm) : WGM;
        u.pm = fm + ((wgid % nig) % gsz); u.pn = (wgid % nig) / gsz; return true;
    }
    __device__ __forceinline__ void a_ready(const Unit&) const {}
    __device__ __forceinline__ void done(const Unit&) const {}
};
__device__ __forceinline__ unsigned cvt_pk_bf16(float lo, float hi) { unsigned r; asm volatile("v_cvt_pk_bf16_f32 %0, %1, %2" : "=v"(r) : "v"(lo), "v"(hi)); return r; }
template <class Epi, class Sched, bool STAMP = false>
__device__ __forceinline__ void gemm_phase(PG8_LAS unsigned char* lds, const Gemm g, const Sched& S, const Epi& E, unsigned long long* stamps) {
    const int tid = launder_v(threadIdx.x), wid = __builtin_amdgcn_readfirstlane(tid >> 6), lane = tid & 63, wr = wid >> 2, wc = wid & 3, fr = lane & 15, fq = lane >> 4;
    const int K = g.K, nt = K / BK;
    int ts_lo = 0, ts_hi = 0, nts = 0; const unsigned long long rt_entry = STAMP ? (unsigned long long)wall_clock64() : 0ull;
#define PG8_STAMP() do { if (STAMP && wid == 0 && nts < 64) { const unsigned long long _c = (unsigned long long)clock64(); \
        ts_lo = (lane == nts) ? (int)(unsigned)_c : ts_lo; ts_hi = (lane == nts) ? (int)(unsigned)(_c >> 32) : ts_hi; ++nts; } } while (0)
    PG8_STAMP();
    unsigned voffA[2], voffB[2];
#pragma unroll
    for (int i = 0; i < 2; ++i) { int R, C; stage_rc(tid * 16 + i * 8192, R, C); const int Rb = Epi::PERM ? ((R & ~31) + perm32(R & 31)) : R;
        voffA[i] = (unsigned)(R * K + C) * 2u; voffB[i] = (unsigned)(Rb * K + C) * 2u; }
    const size_t kstep = (size_t)(BK * 2);
    const size_t hstep = (size_t)HALF * K * 2;
    const size_t tstep = 2 * hstep;
    const unsigned ldsw = (unsigned)wid * 1024u;
    const int aoff = lds_byte(wr * 64 + fr, fq * 8), boff = lds_byte(wc * 32 + fr, fq * 8);
#define PG8_SA(b, h) (((b) * 2 + (h)) * HTB)
#define PG8_SB(b, h) ((4 + (b) * 2 + (h)) * HTB)
#define PG8_STAGE(bufoff, gbase, voff) do { _Pragma("unroll") for (int _i = 0; _i < 2; ++_i) \
        __builtin_amdgcn_global_load_lds((const unsigned*)((const char*)(gbase) + (voff)[_i]), (PG8_LAS unsigned*)(lds + (bufoff) + ldsw + _i * 8192), 16, 0, 0); } while (0)
#define PG8_LDA(dst, b, h) do { _Pragma("unroll") for (int m = 0; m < 4; ++m) _Pragma("unroll") for (int k = 0; k < 2; ++k) dst[m][k] = *(const PG8_LAS bf16x8*)(lds + PG8_SA(b, h) + aoff + m * 2048 + k * 1024); } while (0)
#define PG8_LDB(dst, b, h) do { _Pragma("unroll") for (int n = 0; n < 2; ++n) _Pragma("unroll") for (int k = 0; k < 2; ++k) dst[n][k] = *(const PG8_LAS bf16x8*)(lds + PG8_SB(b, h) + boff + n * 2048 + k * 1024); } while (0)
#define PG8_MMA(ai, bj, At, Bt) do { __builtin_amdgcn_s_setprio(1); _Pragma("unroll") for (int m = 0; m < 4; ++m) _Pragma("unroll") for (int n = 0; n < 2; ++n) _Pragma("unroll") for (int k = 0; k < 2; ++k) \
        acc[ai][bj][m][n] = __builtin_amdgcn_mfma_f32_16x16x32_bf16(Bt[n][k], At[m][k], acc[ai][bj][m][n], 0, 0, 0); __builtin_amdgcn_s_setprio(0); } while (0)
#define PG8_WAIT_V(n) asm volatile("s_waitcnt vmcnt(" #n ")" ::: "memory")
#define PG8_WAIT_L(n) asm volatile("s_waitcnt lgkmcnt(" #n ")" ::: "memory")
#define PG8_BAR __builtin_amdgcn_s_barrier()
#define PG8_SCHED __builtin_amdgcn_sched_barrier(0)
    Unit cur, nxt; int ui = 0;
    if (!S.next(0, cur)) return;
    f32x4 acc[2][2][4][2];
#pragma unroll
    for (int a = 0; a < 2; ++a)
#pragma unroll
        for (int b = 0; b < 2; ++b)
#pragma unroll
            for (int m = 0; m < 4; ++m)
#pragma unroll
                for (int n = 0; n < 2; ++n) acc[a][b][m][n] = (f32x4){0.f, 0.f, 0.f, 0.f};
    bf16x8 At[4][2], B0[2][2], B1[2][2];
    const char* cA = (const char*)g.A + (size_t)cur.pm * tstep; const char* cB = (const char*)g.Bt + (size_t)cur.pn * tstep;
    S.a_ready(cur);
    PG8_STAGE(PG8_SB(0, 0), cB, voffB); PG8_STAGE(PG8_SA(0, 0), cA, voffA); PG8_STAGE(PG8_SB(0, 1), cB + hstep, voffB); PG8_STAGE(PG8_SA(0, 1), cA + hstep, voffA);
    if (wr == 1) PG8_BAR;
    PG8_WAIT_V(4); PG8_BAR;
    PG8_STAGE(PG8_SB(1, 0), cB + kstep, voffB); PG8_STAGE(PG8_SA(1, 0), cA + kstep, voffA); PG8_STAGE(PG8_SB(1, 1), cB + hstep + kstep, voffB);
    PG8_WAIT_V(6); PG8_BAR;
    PG8_STAMP();
    for (;;) {
        const bool has_next = S.next(ui + 1, nxt);
        const char* nA = has_next ? (const char*)g.A + (size_t)nxt.pm * tstep : cA; const char* nB = has_next ? (const char*)g.Bt + (size_t)nxt.pn * tstep : cB;
        for (int t = 0; t < nt; t += 2) {
            const bool last = (t == nt - 2);
            const char* a1 = cA + (size_t)(t + 1) * kstep;
            const char* a2 = last ? nA : cA + (size_t)(t + 2) * kstep; const char* b2 = last ? nB : cB + (size_t)(t + 2) * kstep;
            const char* a3 = a2 + kstep; const char* b3 = b2 + kstep;
            if (last && has_next) S.a_ready(nxt);
            PG8_LDB(B0, 0, 0); PG8_SCHED; PG8_LDA(At, 0, 0); PG8_STAGE(PG8_SA(1, 1), a1 + hstep, voffA);
            PG8_WAIT_L(8); PG8_BAR; PG8_WAIT_L(0); PG8_MMA(0, 0, At, B0); PG8_BAR; PG8_SCHED;
            PG8_LDB(B1, 0, 1); PG8_STAGE(PG8_SB(0, 0), b2, voffB);
            PG8_BAR; PG8_WAIT_L(0); PG8_MMA(0, 1, At, B1); PG8_BAR;
            PG8_LDA(At, 0, 1); PG8_STAGE(PG8_SA(0, 0), a2, voffA);
            PG8_BAR; PG8_WAIT_L(0); PG8_MMA(1, 0, At, B0); PG8_BAR; PG8_SCHED;
            PG8_STAGE(PG8_SB(0, 1), b2 + hstep, voffB);
            PG8_WAIT_V(6); PG8_BAR; PG8_MMA(1, 1, At, B1); PG8_BAR;
            PG8_LDB(B0, 1, 0); PG8_SCHED; PG8_LDA(At, 1, 0); PG8_STAGE(PG8_SA(0, 1), a2 + hstep, voffA);
            PG8_WAIT_L(8); PG8_BAR; PG8_WAIT_L(0); PG8_MMA(0, 0, At, B0); PG8_BAR; PG8_SCHED;
            PG8_LDB(B1, 1, 1); PG8_STAGE(PG8_SB(1, 0), b3, voffB);
            PG8_BAR; PG8_WAIT_L(0); PG8_MMA(0, 1, At, B1); PG8_BAR;
            PG8_LDA(At, 1, 1); PG8_STAGE(PG8_SA(1, 0), a3, voffA);
            PG8_BAR; PG8_WAIT_L(0); PG8_MMA(1, 0, At, B0); PG8_BAR; PG8_SCHED;
            PG8_STAGE(PG8_SB(1, 1), b3 + hstep, voffB);
            PG8_WAIT_V(6); PG8_BAR; PG8_MMA(1, 1, At, B1); PG8_BAR;
        }
        PG8_STAMP();
        if constexpr (!Epi::AFTER_DRAIN) { E(acc, cur, wr, wc, fr, fq); S.done(cur); }
        PG8_STAMP();
        if (!has_next) break;
#pragma unroll
        for (int a = 0; a < 2; ++a)
#pragma unroll
            for (int b = 0; b < 2; ++b)
#pragma unroll
                for (int m = 0; m < 4; ++m)
#pragma unroll
                    for (int n = 0; n < 2; ++n) acc[a][b][m][n] = (f32x4){0.f, 0.f, 0.f, 0.f};
        cur = nxt; cA = nA; cB = nB; ++ui;
    }
    PG8_WAIT_V(0);
    if (wr == 0) PG8_BAR;
    PG8_BAR;
    if constexpr (Epi::AFTER_DRAIN) { E.fused(acc, cur, wr, wc, fr, fq, lds, wid, lane); S.done(cur); }
    PG8_STAMP();
    if (STAMP && wid == 0) { stamps[lane] = lane < nts ? (((unsigned long long)(unsigned)ts_hi << 32) | (unsigned)ts_lo) : 0ull;
        if (lane == 62) stamps[62] = rt_entry; if (lane == 63) stamps[63] = (unsigned long long)wall_clock64(); }
#undef PG8_STAMP
#undef PG8_SA
#undef PG8_SB
#undef PG8_STAGE
#undef PG8_LDA
#undef PG8_LDB
#undef PG8_MMA
#undef PG8_WAIT_V
#undef PG8_WAIT_L
#undef PG8_BAR
#undef PG8_SCHED
}
}

using pg8::bf16_t; using pg8::bf16x8; using pg8::f32x4;
constexpr int MR = 16512, MPAD = 16640;
constexpr int NINP = 4864;
constexpr int C_GLA = 0, C_GMLP = 784, C_RWKV = 1296, C_DIL = 2320;
constexpr float EPS = 1e-6f;

constexpr size_t SZ_WGU1 = (size_t)5632 * 1024 * 2, SZ_WD1 = (size_t)1024 * 2816 * 2, SZ_WIN1 = (size_t)NINP * 1024 * 2, SZ_WOUT1 = (size_t)1024 * 1024 * 2;
constexpr size_t O_WGU = 0;
constexpr size_t O_WD = O_WGU + 4 * SZ_WGU1;
constexpr size_t O_WIN = O_WD + 4 * SZ_WD1;
constexpr size_t O_WOUT = O_WIN + 2 * SZ_WIN1;
constexpr size_t O_XN = O_WOUT + 2 * SZ_WOUT1;
constexpr size_t O_ACT = O_XN + (size_t)MPAD * 1024 * 2;
constexpr size_t O_F = O_ACT + (size_t)MPAD * 2816 * 2;
constexpr size_t O_H = O_F + (size_t)MPAD * 1024 * 4;
constexpr size_t O_COLS = O_H + (size_t)MR * 1024 * 4;
constexpr size_t O_MIX = O_COLS + (size_t)MPAD * NINP * 2;
constexpr size_t O_SSP = O_MIX + (size_t)MPAD * 1024 * 2;
constexpr size_t O_SSPT = O_SSP + (size_t)16384 * 16 * 4;
constexpr size_t O_LSE = O_SSPT + (size_t)128 * 32 * 4;
constexpr size_t O_BON = O_LSE + (size_t)3 * MR * 4 * 4;
constexpr size_t O_CTR = O_BON + (size_t)MR * 4 * 4;
constexpr size_t O_BAR = O_CTR + 256;
constexpr size_t O_LRW = O_BAR + (size_t)3456 * 4 + 256;
constexpr size_t SZ_LRW1 = (size_t)65536 * 2;
constexpr size_t O_GINC = O_LRW + 2 * SZ_LRW1;
constexpr size_t O_GDEC = O_GINC + (size_t)1024 * 2048 * 4;
constexpr size_t WS_END = O_GDEC + (size_t)1024 * 32 * 4;
constexpr size_t SZ_RW = (size_t)MR * 256 * 4;
constexpr size_t O_RR = O_ACT, O_RWD = O_ACT + SZ_RW, O_RK = O_ACT + 2 * SZ_RW, O_RV = O_ACT + 3 * SZ_RW, O_RG = O_ACT + 4 * SZ_RW;
constexpr size_t O_RA = O_F, O_RB = O_F + SZ_RW, O_RY = O_F + 2 * SZ_RW;
constexpr size_t O_DILO = O_XN;
static_assert(5 * SZ_RW <= (size_t)MPAD * 2816 * 2, "rwkv alias");
static_assert(3 * SZ_RW <= (size_t)MPAD * 1024 * 4, "rwkv alias 2");
static_assert((size_t)3 * MR * 256 * 2 <= (size_t)MR * 1024 * 2, "dilo alias");

constexpr size_t OUT_YP = 0;
constexpr size_t OUT_YS = OUT_YP + (size_t)8 * 2048 * 1024;
constexpr size_t OUT_PGLA = OUT_YS + (size_t)32 * 4 * 1024;
constexpr size_t OUT_PRWKV = OUT_PGLA + (size_t)2 * 8 * 4 * 32 * 64;
constexpr size_t OUT_PSHIFT = OUT_PRWKV + (size_t)2 * 8 * 4 * 64 * 64;
constexpr size_t OUT_PW128 = OUT_PSHIFT + (size_t)2 * 8 * 1024;
constexpr size_t OUT_PW512 = OUT_PW128 + (size_t)2 * 8 * 128 * 512;
constexpr size_t OUT_PW2048 = OUT_PW512 + (size_t)2 * 8 * 512 * 512;
constexpr size_t OUT_SGLA = OUT_PW2048 + (size_t)2 * 8 * 2048 * 512;
constexpr size_t OUT_SRWKV = OUT_SGLA + (size_t)2 * 32 * 4 * 32 * 64;
constexpr size_t OUT_SSHIFT = OUT_SRWKV + (size_t)2 * 32 * 4 * 64 * 64;
constexpr size_t OUT_SW128 = OUT_SSHIFT + (size_t)2 * 32 * 1024;
constexpr size_t OUT_SW512 = OUT_SW128 + (size_t)2 * 32 * 4 * 512;
constexpr size_t OUT_SW2048 = OUT_SW512 + (size_t)2 * 32 * 4 * 512;
constexpr size_t OUT_SGV = OUT_SW2048 + (size_t)2 * 32 * 4 * 512;
constexpr size_t OUT_END = OUT_SGV + (size_t)2 * 32 * 4 * 256;

constexpr int LDS_BYTES = 131072;

struct Params { const float* in[32]; float* out; unsigned char* ws; int ph_lo, ph_hi; };
struct Ctx { const gfptr_t* tab; float* out; unsigned char* ws;
    __device__ __forceinline__ const float* in(int i) const { return (const float*)tab[i]; } };

__device__ __forceinline__ float bf2f(bf16_t b) { return __uint_as_float(((unsigned)b) << 16); }
__device__ __forceinline__ bf16_t f2bf(float f) { unsigned u = __float_as_uint(f); u += 0x7FFFu + ((u >> 16) & 1u); return (bf16_t)(u >> 16); }
__device__ __forceinline__ unsigned pack2(float lo, float hi) { return pg8::cvt_pk_bf16(lo, hi); }
__device__ __forceinline__ float wave_sum(float x) {
#pragma unroll
    for (int o = 32; o > 0; o >>= 1) x += __shfl_xor(x, o);
    return x;
}
__device__ __forceinline__ float wave_max(float x) {
#pragma unroll
    for (int o = 32; o > 0; o >>= 1) x = fmaxf(x, __shfl_xor(x, o));
    return x;
}
template <int CTRL> __device__ __forceinline__ float dppf(float x) { return __builtin_bit_cast(float, __builtin_amdgcn_mov_dpp(__builtin_bit_cast(int, x), CTRL, 0xf, 0xf, true)); }
__device__ __forceinline__ float red4_sum(float x) { x += dppf<0xB1>(x); x += dppf<0x4E>(x); return x; }
__device__ __forceinline__ float red8_sum(float x) { x += dppf<0xB1>(x); x += dppf<0x4E>(x); x += dppf<0x141>(x); return x; }
__device__ __forceinline__ float red16_sum(float x) { x += dppf<0xB1>(x); x += dppf<0x4E>(x); x += dppf<0x141>(x); x += dppf<0x128>(x); return x; }
__device__ __forceinline__ float red16_max(float x) { x = fmaxf(x, dppf<0xB1>(x)); x = fmaxf(x, dppf<0x4E>(x)); x = fmaxf(x, dppf<0x141>(x)); x = fmaxf(x, dppf<0x128>(x)); return x; }
__device__ __forceinline__ float sigm(float x) { return __builtin_amdgcn_rcpf(1.f + __expf(-x)); }
__device__ __forceinline__ float gelu_e(float v) {
    const float av = fabsf(v), t = __builtin_amdgcn_rcpf(av * 0.2316418882f + 1.0f);
    float q = t * 0.5307027145f + (-0.7265760135f); q = q * t + 0.7107068705f; q = q * t + (-0.142248368f); q = q * t + 0.127414796f; q = q * t;
    const float e = __builtin_amdgcn_exp2f(v * v * (-0.72134752044f)), m = v * (q * e);
    return v < 0.f ? m : v - m;
}
__device__ __forceinline__ float silu_f(float x) { return x * __builtin_amdgcn_rcpf(1.f + __expf(-x)); }
__device__ __forceinline__ bf16x8 ldfrag(const bf16_t* base, int ld, int row0, int k0, int lane) { return *(const bf16x8*)(base + (row0 + (lane & 15)) * ld + k0 + (lane >> 4) * 8); }
__device__ __forceinline__ f32x4 mma16(bf16x8 a, bf16x8 b, f32x4 c) { return __builtin_amdgcn_mfma_f32_16x16x32_bf16(a, b, c, 0, 0, 0); }

struct EpiSwiGLU {
    static constexpr bool PERM = true, AFTER_DRAIN = false;
    bf16_t* O;
    __device__ __forceinline__ void operator()(const f32x4 (&acc)[2][2][4][2], const pg8::Unit& u, int wr, int wc, int fr, int fq) const {
        const int row0 = u.pm * 256 + wr * 64 + fr, col0 = u.pn * 128 + wc * 32 + 8 * fq;
#pragma unroll
        for (int ai = 0; ai < 2; ++ai)
#pragma unroll
            for (int m = 0; m < 4; ++m) {
                bf16_t* rowp = O + (size_t)(row0 + ai * 128 + m * 16) * 2816 + col0;
                const f32x4 g0 = acc[ai][0][m][0], g1 = acc[ai][0][m][1], u0 = acc[ai][1][m][0], u1 = acc[ai][1][m][1];
                float r[8];
#pragma unroll
                for (int i = 0; i < 4; ++i) { r[i] = silu_f(g0[i]) * u0[i]; r[4 + i] = silu_f(g1[i]) * u1[i]; }
                uint4 w; w.x = pack2(r[0], r[1]); w.y = pack2(r[2], r[3]); w.z = pack2(r[4], r[5]); w.w = pack2(r[6], r[7]);
                *(uint4*)rowp = w;
            }
    }
};
struct EpiBf16P {
    static constexpr bool PERM = true, AFTER_DRAIN = false;
    bf16_t* O; int ldc;
    __device__ __forceinline__ void operator()(const f32x4 (&acc)[2][2][4][2], const pg8::Unit& u, int wr, int wc, int fr, int fq) const {
        const int row0 = u.pm * 256 + wr * 64 + fr, col0 = u.pn * 256 + wc * 32 + 8 * fq;
#pragma unroll
        for (int ai = 0; ai < 2; ++ai)
#pragma unroll
            for (int m = 0; m < 4; ++m) {
                bf16_t* rowp = O + (size_t)(row0 + ai * 128 + m * 16) * ldc + col0;
#pragma unroll
                for (int bj = 0; bj < 2; ++bj) {
                    const f32x4 v0 = acc[ai][bj][m][0], v1 = acc[ai][bj][m][1];
                    uint4 w; w.x = pack2(v0[0], v0[1]); w.y = pack2(v0[2], v0[3]); w.z = pack2(v1[0], v1[1]); w.w = pack2(v1[2], v1[3]);
                    *(uint4*)(rowp + bj * 128) = w;
                }
            }
    }
};
struct EpiBf16SS {
    static constexpr bool PERM = true, AFTER_DRAIN = false;
    bf16_t* C; float* ssp;
    __device__ __forceinline__ void operator()(const f32x4 (&acc)[2][2][4][2], const pg8::Unit& u, int wr, int wc, int fr, int fq) const {
        const int row0 = u.pm * 256 + wr * 64 + fr, col0 = u.pn * 256 + wc * 32 + 8 * fq;
#pragma unroll
        for (int ai = 0; ai < 2; ++ai)
#pragma unroll
            for (int m = 0; m < 4; ++m) {
                const int row = row0 + ai * 128 + m * 16;
                bf16_t* rowp = C + (size_t)row * 1024 + col0;
                float s = 0.f;
#pragma unroll
                for (int bj = 0; bj < 2; ++bj) {
                    const f32x4 v0 = acc[ai][bj][m][0], v1 = acc[ai][bj][m][1];
                    s += (v0[0] * v0[0] + v0[1] * v0[1]) + (v0[2] * v0[2] + v0[3] * v0[3]) + (v1[0] * v1[0] + v1[1] * v1[1]) + (v1[2] * v1[2] + v1[3] * v1[3]);
                    uint4 w; w.x = pack2(v0[0], v0[1]); w.y = pack2(v0[2], v0[3]); w.z = pack2(v1[0], v1[1]); w.w = pack2(v1[2], v1[3]);
                    *(uint4*)(rowp + bj * 128) = w;
                }
                s += __shfl_xor(s, 16); s += __shfl_xor(s, 32);
                if (fq == 0) ssp[(size_t)row * 16 + u.pn * 4 + wc] = s;
            }
    }
};

struct CvtD { const float* sp; bf16_t* dp; int ldn; bool ok; };
__device__ __forceinline__ CvtD cvt_decode(const Ctx& p, int t) {
    const int tid = threadIdx.x;
        const float* src; bf16_t* dst; int ldn, nvalid, K, k0, n0, drow0;
        if (t < 4224) {
            const int blk = t / 1056, r = t % 1056, which = r / 352, tt = r % 352;
            if (which < 2) { src = p.in(9 + which) + (size_t)blk * 1024 * 2816; ldn = 2816; nvalid = 2816; K = 1024; k0 = (tt / 22) * 64; n0 = (tt % 22) * 128;
                dst = (bf16_t*)(p.ws + O_WGU + blk * SZ_WGU1); drow0 = (n0 >> 7) * 256 + which * 128; }
            else { src = p.in(11) + (size_t)blk * 2816 * 1024; ldn = 1024; nvalid = 1024; K = 2816; k0 = (tt / 8) * 64; n0 = (tt % 8) * 128;
                dst = (bf16_t*)(p.ws + O_WD + blk * SZ_WD1); drow0 = n0; }
        } else if (t < 5440) {
            const int u = t - 4224, l = u / 608, tt = u % 608;
            src = p.in(12) + (size_t)l * 1024 * 4624; ldn = 4624; nvalid = 4624; K = 1024; k0 = (tt / 38) * 64; n0 = (tt % 38) * 128;
            dst = (bf16_t*)(p.ws + O_WIN + l * SZ_WIN1); drow0 = n0;
        } else if (t >= 5696) {
            const int u = t - 5696, l = u >> 3, tt = u & 7;
            bf16_t* base = (bf16_t*)(p.ws + O_LRW + l * SZ_LRW1);
            ldn = 256; nvalid = 256;
            if (tt < 2) { src = p.in(23) + (size_t)l * 64 * 256; K = 64; k0 = 0; n0 = tt * 128; dst = base; }
            else if (tt < 4) { src = p.in(25) + (size_t)l * 64 * 256; K = 64; k0 = 0; n0 = (tt - 2) * 128; dst = base + 16384; }
            else { src = p.in(26) + (size_t)l * 128 * 256; K = 128; k0 = ((tt - 4) >> 1) * 64; n0 = ((tt - 4) & 1) * 128; dst = base + 32768; }
            drow0 = n0;
        } else {
            const int u = t - 5440, l = u / 128, tt = u % 128;
            src = p.in(13) + (size_t)l * 1024 * 1024; ldn = 1024; nvalid = 1024; K = 1024; k0 = (tt / 8) * 64; n0 = (tt % 8) * 128;
            dst = (bf16_t*)(p.ws + O_WOUT + l * SZ_WOUT1); drow0 = n0;
        }
        CvtD d; const int n = n0 + (tid & 127); d.ok = n < nvalid;
        d.sp = src + (size_t)(k0 + (tid >> 7)) * ldn + (d.ok ? n : 0);
        d.dp = dst + (size_t)(drow0 + (tid >> 2)) * K + k0 + (tid & 3) * 16;
        d.ldn = ldn; return d;
}
__device__ __forceinline__ void cvt_load(const CvtD& d, float (&v)[16]) {
#pragma unroll
    for (int i = 0; i < 16; ++i) v[i] = d.sp[(size_t)(i * 4) * d.ldn];
}
__device__ __forceinline__ void cvt_finish(const CvtD& d, const float (&v)[16], float* sT) {
    const int tid = threadIdx.x, nn = tid & 127;
#pragma unroll
    for (int i = 0; i < 16; ++i) sT[(i * 4 + (tid >> 7)) * 129 + nn] = d.ok ? v[i] : 0.f;
    __syncthreads();
    const int nl = tid >> 2, kg = tid & 3;
    float x[16];
#pragma unroll
    for (int j = 0; j < 16; ++j) x[j] = sT[(kg * 16 + j) * 129 + nl];
    uint4 w0, w1;
    w0.x = pack2(x[0], x[1]); w0.y = pack2(x[2], x[3]); w0.z = pack2(x[4], x[5]); w0.w = pack2(x[6], x[7]);
    w1.x = pack2(x[8], x[9]); w1.y = pack2(x[10], x[11]); w1.z = pack2(x[12], x[13]); w1.w = pack2(x[14], x[15]);
    uint4* dp = (uint4*)d.dp; dp[0] = w0; dp[1] = w1;
    __syncthreads();
}

__device__ __forceinline__ void phase_prologue(const Ctx& p, unsigned char* smem) {
    const int tid = launder_v(threadIdx.x), bid = blockIdx.x, nb = gridDim.x;
    float* sT = (float*)smem;
    {
        int t = bid; float v[16];
        CvtD d = cvt_decode(p, launder_v(t < 5712 ? t : 0));
        if (t < 5712) cvt_load(d, v);
        for (; t < 5712; t += nb) {
            const int tn = t + nb; float vn[16];
            const CvtD dn = cvt_decode(p, launder_v(tn < 5712 ? tn : 0));
            if (tn < 5712) cvt_load(dn, vn);
            cvt_finish(d, v, sT);
            d = dn;
#pragma unroll
            for (int i = 0; i < 16; ++i) v[i] = vn[i];
        }
    }
    const int wave = tid >> 6, lane = tid & 63;
    const float* g0 = p.in(8);
    bf16_t* XN = (bf16_t*)(p.ws + O_XN); bf16_t* MIX = (bf16_t*)(p.ws + O_MIX);
    float4 g4[4];
#pragma unroll
    for (int j = 0; j < 4; ++j) g4[j] = *(const float4*)(g0 + j * 256 + lane * 4);
    const int rstep = nb * 8;
    float4 nv[4];
    auto load_x = [&](int r) { const float* x = r < 16384 ? p.in(0) + (size_t)r * 1024 : p.in(1) + (size_t)(r - 16384) * 1024;
#pragma unroll
        for (int j = 0; j < 4; ++j) nv[j] = *(const float4*)(x + j * 256 + lane * 4); };
    int row = bid * 8 + wave;
    if (row < MR) load_x(row);
    for (; row < MPAD; row += rstep) {
        bf16_t* xo = XN + (size_t)row * 1024;
        if (row < MR) {
            float4 v[4]; float ss = 0.f;
#pragma unroll
            for (int j = 0; j < 4; ++j) { v[j] = nv[j]; ss += v[j].x * v[j].x + v[j].y * v[j].y + v[j].z * v[j].z + v[j].w * v[j].w; }
            ss = wave_sum(ss);
            if (row + rstep < MR) load_x(row + rstep);
            const float rs = rsqrtf(ss * (1.f / 1024.f) + EPS);
#pragma unroll
            for (int j = 0; j < 4; ++j) { const float4 g = g4[j];
                uint2 o; o.x = pack2(v[j].x * rs * g.x, v[j].y * rs * g.y); o.y = pack2(v[j].z * rs * g.z, v[j].w * rs * g.w);
                *(uint2*)(xo + j * 256 + lane * 4) = o; }
        } else {
            bf16_t* mo = MIX + (size_t)row * 1024;
#pragma unroll
            for (int j = 0; j < 4; ++j) { *(uint2*)(xo + j * 256 + lane * 4) = make_uint2(0u, 0u); *(uint2*)(mo + j * 256 + lane * 4) = make_uint2(0u, 0u); }
        }
    }
}

__device__ __forceinline__ void phase_ew(const Ctx& p, int l, int kind) {
    const int tid = launder_v(threadIdx.x), wave = tid >> 6, lane = tid & 63;
    const float* ng = p.in(8) + (size_t)l * 6 * 1024;
    const float* gpost = ng + (kind == 0 ? 1 : (kind == 1 ? 3 : 5)) * 1024;
    const float* gpre = kind == 0 ? ng + 2 * 1024 : (kind == 1 ? ng + 4 * 1024 : (l == 0 ? p.in(8) + 6 * 1024 : nullptr));
    const float scale = kind == 1 ? 1.f : 0.5f;
    bf16_t* H = (bf16_t*)(p.ws + O_H); const bf16_t* F = (const bf16_t*)(p.ws + O_F);
    const float* SSP = (const float*)(p.ws + O_SSP); const float* SSPT = (const float*)(p.ws + O_SSPT);
    bf16_t* XN = (bf16_t*)(p.ws + O_XN);
    const bool from_x = (kind == 0 && l == 0), to_out = (kind == 2 && l == 1);
    const float* xin0 = p.in(0); const float* xin1 = p.in(1);
    float4 gp[4], gq[4];
#pragma unroll
    for (int j = 0; j < 4; ++j) { const int c = j * 256 + lane * 4; gp[j] = *(const float4*)(gpost + c); gq[j] = gpre ? *(const float4*)(gpre + c) : make_float4(0.f, 0.f, 0.f, 0.f); }
    const int step = gridDim.x * 8;
    int row = blockIdx.x * 8 + wave;
    float4 fA[4], rA[4], fB[4], rB[4]; float sA = 0.f, sB = 0.f;
    auto load_row = [&](int r, float4 (&fv)[4], float4 (&rv)[4], float& ssl) {
        if (r < 16384) ssl = lane < 16 ? SSP[(size_t)r * 16 + lane] : 0.f; else ssl = lane < 32 ? SSPT[(size_t)(r - 16384) * 32 + lane] : 0.f;
        const float* resx = r < 16384 ? xin0 + (size_t)r * 1024 : xin1 + (size_t)(r - 16384) * 1024;
#pragma unroll
        for (int j = 0; j < 4; ++j) { const int c = j * 256 + lane * 4;
            const uint2 fw = *(const uint2*)(F + (size_t)r * 1024 + c);
            fv[j] = make_float4(__uint_as_float(fw.x << 16), __uint_as_float(fw.x & 0xffff0000u), __uint_as_float(fw.y << 16), __uint_as_float(fw.y & 0xffff0000u));
            if (from_x) rv[j] = *(const float4*)(resx + c);
            else { const uint2 hw = *(const uint2*)(H + (size_t)r * 1024 + c);
                rv[j] = make_float4(__uint_as_float(hw.x << 16), __uint_as_float(hw.x & 0xffff0000u), __uint_as_float(hw.y << 16), __uint_as_float(hw.y & 0xffff0000u)); } }
    };
    auto do_row = [&](int r, float4 (&fv)[4], float4 (&rv)[4], float& ssl) {
        float4 f[4], r4[4];
#pragma unroll
        for (int j = 0; j < 4; ++j) { f[j] = fv[j]; r4[j] = rv[j]; }
        const float ss = wave_sum(ssl);
        if (r + 2 * step < MR) load_row(r + 2 * step, fv, rv, ssl);
        const float rs = rsqrtf(ss * (1.f / 1024.f) + EPS) * scale;
        float4 hv[4]; float s2 = 0.f;
#pragma unroll
        for (int j = 0; j < 4; ++j) {
            float4 h; h.x = r4[j].x + f[j].x * rs * gp[j].x; h.y = r4[j].y + f[j].y * rs * gp[j].y; h.z = r4[j].z + f[j].z * rs * gp[j].z; h.w = r4[j].w + f[j].w * rs * gp[j].w;
            hv[j] = h; s2 += h.x * h.x + h.y * h.y + h.z * h.z + h.w * h.w;
            if (to_out) *(float4*)(p.out + (size_t)r * 1024 + j * 256 + lane * 4) = h;
            else { uint2 o; o.x = pack2(h.x, h.y); o.y = pack2(h.z, h.w); *(uint2*)(H + (size_t)r * 1024 + j * 256 + lane * 4) = o; }
        }
        if (gpre) {
            s2 = wave_sum(s2);
            const float r2 = rsqrtf(s2 * (1.f / 1024.f) + EPS);
#pragma unroll
            for (int j = 0; j < 4; ++j) { const int c = j * 256 + lane * 4;
                uint2 o; o.x = pack2(hv[j].x * r2 * gq[j].x, hv[j].y * r2 * gq[j].y); o.y = pack2(hv[j].z * r2 * gq[j].z, hv[j].w * r2 * gq[j].w);
                *(uint2*)(XN + (size_t)r * 1024 + c) = o; }
        }
    };
    if (row < MR) load_row(row, fA, rA, sA);
    if (row + step < MR) load_row(row + step, fB, rB, sB);
    for (; row < MR; row += 2 * step) {
        do_row(row, fA, rA, sA);
        if (row + step < MR) do_row(row + step, fB, rB, sB);
    }
}

__device__ __forceinline__ void tail_gemm(const bf16_t* __restrict__ A, const bf16_t* __restrict__ Bt, int K, bf16_t* __restrict__ F, float* __restrict__ SSPT, unsigned char* smem) {
    const int tid = launder_v(threadIdx.x), wave = tid >> 6, lane = tid & 63, fr = lane & 15, fq = lane >> 4;
    float* red = (float*)smem;
    for (int item = blockIdx.x; item < 256; item += gridDim.x) {
        const int rg = item >> 5, cgp = item & 31;
        const bf16_t* Ap = A + (size_t)(16384 + rg * 16 + fr) * K + fq * 8;
        const bf16_t* B0 = Bt + (size_t)(cgp * 32 + fr) * K + fq * 8;
        const bf16_t* B1 = B0 + (size_t)16 * K;
        const int kper = K >> 3, kbeg = wave * kper;
        f32x4 acc0 = {0.f, 0.f, 0.f, 0.f}, acc1 = {0.f, 0.f, 0.f, 0.f};
        if (kper == 352) {
            bf16x8 av[11], b0v[11], b1v[11];
#pragma unroll
            for (int i = 0; i < 11; ++i) { av[i] = *(const bf16x8*)(Ap + kbeg + i * 32); b0v[i] = *(const bf16x8*)(B0 + kbeg + i * 32); b1v[i] = *(const bf16x8*)(B1 + kbeg + i * 32); }
#pragma unroll
            for (int i = 0; i < 11; ++i) { acc0 = mma16(av[i], b0v[i], acc0); acc1 = mma16(av[i], b1v[i], acc1); }
        } else {
            bf16x8 av[4], b0v[4], b1v[4];
#pragma unroll
            for (int i = 0; i < 4; ++i) { av[i] = *(const bf16x8*)(Ap + kbeg + i * 32); b0v[i] = *(const bf16x8*)(B0 + kbeg + i * 32); b1v[i] = *(const bf16x8*)(B1 + kbeg + i * 32); }
#pragma unroll
            for (int i = 0; i < 4; ++i) { acc0 = mma16(av[i], b0v[i], acc0); acc1 = mma16(av[i], b1v[i], acc1); }
        }
#pragma unroll
        for (int j = 0; j < 4; ++j) { red[wave * 512 + (fq * 4 + j) * 32 + fr] = acc0[j]; red[wave * 512 + (fq * 4 + j) * 32 + 16 + fr] = acc1[j]; }
        __syncthreads();
        float s = 0.f;
#pragma unroll
        for (int w = 0; w < 8; ++w) s += red[w * 512 + tid];
        const int row = tid >> 5, col = tid & 31;
        F[(size_t)(16384 + rg * 16 + row) * 1024 + cgp * 32 + col] = f2bf(s);
        float q = s * s;
        q += __shfl_xor(q, 1); q += __shfl_xor(q, 2); q += __shfl_xor(q, 4); q += __shfl_xor(q, 8); q += __shfl_xor(q, 16);
        if (col == 0) SSPT[(rg * 16 + row) * 32 + cgp] = q;
        __syncthreads();
    }
}
#ifndef REPMASK
#define REPMASK 0
#endif
#ifndef EXTRA_SYNC
#define EXTRA_SYNC 0
#endif
#ifndef DUP_SMALL
#define DUP_SMALL 0
#endif
#ifndef DUP_RWKV
#define DUP_RWKV 0
#endif
#ifndef TPROBE
#define TPROBE 0
#endif
#ifndef SPLIT_MAIN
#define SPLIT_MAIN 0
#endif
#ifndef DUP_PRE
#define DUP_PRE 0
#endif
#define DUP_PRE_N (DUP_PRE == 1 ? 1032 : (DUP_PRE == 2 ? 1024 : 0))

__device__ __forceinline__ void rwkv_pre_item(const Ctx& p, int l, int item, unsigned char* smem) {
    const int tid = launder_v(threadIdx.x), wave = tid >> 6, lane = tid & 63, fr = lane & 15, fq = lane >> 4;
    constexpr int XRS = 772;
    float* xr = (float*)smem;
    bf16_t* lr = (bf16_t*)(smem + 16 * XRS * 4);
    float* part = (float*)(smem + 16 * XRS * 4 + 16 * 264 * 2);
    const bf16_t* COLS = (const bf16_t*)(p.ws + O_COLS);
    const float* mu = p.in(21) + l * 1024;
    const int r0 = item * 16;
    const bf16_t* LW = (const bf16_t*)(p.ws + O_LRW + l * SZ_LRW1);
    bf16x8 bw[2][2], ba[2][2], bg[2][4];
#pragma unroll
    for (int c2 = 0; c2 < 2; ++c2) { const int ct = wave * 2 + c2;
#pragma unroll
        for (int ks = 0; ks < 2; ++ks) { bw[c2][ks] = *(const bf16x8*)(LW + (ct * 16 + fr) * 64 + ks * 32 + fq * 8); ba[c2][ks] = *(const bf16x8*)(LW + 16384 + (ct * 16 + fr) * 64 + ks * 32 + fq * 8); }
#pragma unroll
        for (int ks = 0; ks < 4; ++ks) bg[c2][ks] = *(const bf16x8*)(LW + 32768 + (ct * 16 + fr) * 128 + ks * 32 + fq * 8); }
    float4 cst[2][5];
#pragma unroll
    for (int c2 = 0; c2 < 2; ++c2) { const int col0 = l * 256 + wave * 32 + c2 * 16 + fq * 4;
        cst[c2][0] = *(const float4*)(p.in(22) + col0); cst[c2][1] = *(const float4*)(p.in(24) + col0); cst[c2][2] = *(const float4*)(p.in(27) + col0); cst[c2][3] = *(const float4*)(p.in(28) + col0); cst[c2][4] = *(const float4*)(p.in(29) + col0); }
    uint4 cwv[4], pwv[4]; uint4 kvw[6];
    const float4 mu0 = *(const float4*)(mu + (tid & 127) * 8), mu1 = *(const float4*)(mu + (tid & 127) * 8 + 4);
#pragma unroll
    for (int i = 0; i < 4; ++i) {
        const int idx = tid + i * 512, tok = idx >> 7, c8 = (idx & 127) * 8, row = r0 + tok;
        cwv[i] = *(const uint4*)(COLS + (size_t)row * NINP + C_RWKV + c8);
        const int t = row < 16384 ? (row & 2047) : ((row - 16384) & 3);
        pwv[i] = make_uint4(0, 0, 0, 0);
        if (t > 0) pwv[i] = *(const uint4*)(COLS + (size_t)(row - 1) * NINP + C_RWKV + c8);
    }
#pragma unroll
    for (int i = 0; i < 6; ++i) { const int idx = tid + i * 512, tok = idx / 192, rem = idx % 192, gi = rem >> 6, cc = (rem & 63) * 8, row = r0 + tok;
        kvw[i] = *(const uint4*)(COLS + (size_t)row * NINP + C_DIL + gi * 768 + 256 + cc); }
#pragma unroll
    for (int i = 0; i < 4; ++i) {
        const int idx = tid + i * 512, tok = idx >> 7, c8 = (idx & 127) * 8, row = r0 + tok;
        float cv[8], pv[8];
        { const unsigned ww[4] = {cwv[i].x, cwv[i].y, cwv[i].z, cwv[i].w};
#pragma unroll
            for (int k = 0; k < 4; ++k) { cv[2 * k] = __uint_as_float(ww[k] << 16); cv[2 * k + 1] = __uint_as_float(ww[k] & 0xffff0000u); } }
        int t, b; bool last; float* shout; bool usestate = false;
        if (row < 16384) { t = row & 2047; b = row >> 11; last = (t == 2047); shout = p.out + OUT_PSHIFT + (size_t)(l * 8 + b) * 1024 + c8; }
        else { const int rr = row - 16384; t = rr & 3; b = rr >> 2; last = (t == 3); shout = p.out + OUT_SSHIFT + (size_t)(l * 32 + b) * 1024 + c8; usestate = (t == 0); }
        if (usestate) { const float4 s0 = *(const float4*)(p.in(7) + (size_t)(l * 32 + b) * 1024 + c8), s1 = *(const float4*)(p.in(7) + (size_t)(l * 32 + b) * 1024 + c8 + 4);
            pv[0] = s0.x; pv[1] = s0.y; pv[2] = s0.z; pv[3] = s0.w; pv[4] = s1.x; pv[5] = s1.y; pv[6] = s1.z; pv[7] = s1.w; }
        else { const unsigned ww[4] = {pwv[i].x, pwv[i].y, pwv[i].z, pwv[i].w};
#pragma unroll
            for (int k = 0; k < 4; ++k) { pv[2 * k] = __uint_as_float(ww[k] << 16); pv[2 * k + 1] = __uint_as_float(ww[k] & 0xffff0000u); } }
        if (last) { *(float4*)shout = make_float4(cv[0], cv[1], cv[2], cv[3]); *(float4*)(shout + 4) = make_float4(cv[4], cv[5], cv[6], cv[7]); }
        const float mm[8] = {mu0.x, mu0.y, mu0.z, mu0.w, mu1.x, mu1.y, mu1.z, mu1.w};
        float xm[8];
#pragma unroll
        for (int k = 0; k < 8; ++k) xm[k] = cv[k] + (pv[k] - cv[k]) * mm[k];
        if (c8 < 768) { *(float4*)(xr + tok * XRS + c8) = make_float4(xm[0], xm[1], xm[2], xm[3]); *(float4*)(xr + tok * XRS + c8 + 4) = make_float4(xm[4], xm[5], xm[6], xm[7]); }
        else {
            if (c8 < 832) {
#pragma unroll
                for (int k = 0; k < 8; ++k) xm[k] = 1.f - 2.f * __builtin_amdgcn_rcpf(1.f + __expf(2.f * xm[k])); }
            else if (c8 >= 896) {
#pragma unroll
                for (int k = 0; k < 8; ++k) xm[k] = sigm(xm[k]); }
            uint4 w; w.x = pack2(xm[0], xm[1]); w.y = pack2(xm[2], xm[3]); w.z = pack2(xm[4], xm[5]); w.w = pack2(xm[6], xm[7]);
            *(uint4*)(lr + tok * 264 + (c8 - 768)) = w;
        }
    }
#pragma unroll
    for (int i = 0; i < 6; ++i) {
        const int idx = tid + i * 512, tok = idx / 192, rem = idx % 192, gi = rem >> 6, cc = (rem & 63) * 8, row = r0 + tok;
        const uint4 cw = kvw[i];
        const float4 f0 = make_float4(__uint_as_float(cw.x << 16), __uint_as_float(cw.x & 0xffff0000u), __uint_as_float(cw.y << 16), __uint_as_float(cw.y & 0xffff0000u));
        const float4 f1 = make_float4(__uint_as_float(cw.z << 16), __uint_as_float(cw.z & 0xffff0000u), __uint_as_float(cw.w << 16), __uint_as_float(cw.w & 0xffff0000u));
        float* dst = nullptr;
        if (row < 16384) {
            const int t = row & 2047, b = row >> 11, W = gi == 0 ? 128 : (gi == 1 ? 512 : 2048);
            const size_t base = gi == 0 ? OUT_PW128 : (gi == 1 ? OUT_PW512 : OUT_PW2048);
            if (t >= 2048 - W) dst = p.out + base + ((size_t)(l * 8 + b) * W + (t - (2048 - W))) * 512 + cc;
        } else {
            const int rr = row - 16384, t = rr & 3, b = rr >> 2;
            const size_t base = gi == 0 ? OUT_SW128 : (gi == 1 ? OUT_SW512 : OUT_SW2048);
            dst = p.out + base + ((size_t)(l * 32 + b) * 4 + t) * 512 + cc;
        }
        if (dst) { *(float4*)dst = f0; *(float4*)(dst + 4) = f1; }
    }
    __syncthreads();
    f32x4 aw[2], aa[2], ag[2];
#pragma unroll
    for (int c2 = 0; c2 < 2; ++c2) {
        aw[c2] = (f32x4){0.f, 0.f, 0.f, 0.f}; aa[c2] = aw[c2]; ag[c2] = aw[c2];
#pragma unroll
        for (int ks = 0; ks < 2; ++ks) {
            aw[c2] = mma16(bw[c2][ks], ldfrag(lr, 264, 0, ks * 32, lane), aw[c2]);
            aa[c2] = mma16(ba[c2][ks], ldfrag(lr, 264, 0, 64 + ks * 32, lane), aa[c2]);
        }
#pragma unroll
        for (int ks = 0; ks < 4; ++ks) ag[c2] = mma16(bg[c2][ks], ldfrag(lr, 264, 0, 128 + ks * 32, lane), ag[c2]);
    }
    float* RR = (float*)(p.ws + O_RR); float* RWD = (float*)(p.ws + O_RWD); float* RK = (float*)(p.ws + O_RK); float* RV = (float*)(p.ws + O_RV);
    float* RG = (float*)(p.ws + O_RG); float* RA = (float*)(p.ws + O_RA); float* RB = (float*)(p.ws + O_RB); float* BON = (float*)(p.ws + O_BON);
    const int tok = fr; const size_t row = (size_t)(r0 + tok);
    float kkv[2][4], av[2][4]; float pk2 = 0.f, pb = 0.f;
#pragma unroll
    for (int c2 = 0; c2 < 2; ++c2) {
        const int col0 = wave * 32 + c2 * 16 + fq * 4;
        const float4 r4 = *(const float4*)(xr + tok * XRS + col0), k4 = *(const float4*)(xr + tok * XRS + 256 + col0), v4 = *(const float4*)(xr + tok * XRS + 512 + col0);
        const float rr[4] = {r4.x, r4.y, r4.z, r4.w}, kx[4] = {k4.x, k4.y, k4.z, k4.w};
        const float w0c[4] = {cst[c2][0].x, cst[c2][0].y, cst[c2][0].z, cst[c2][0].w}, a0c[4] = {cst[c2][1].x, cst[c2][1].y, cst[c2][1].z, cst[c2][1].w};
        const float kkc[4] = {cst[c2][2].x, cst[c2][2].y, cst[c2][2].z, cst[c2][2].w}, kac[4] = {cst[c2][3].x, cst[c2][3].y, cst[c2][3].z, cst[c2][3].w}, rkc[4] = {cst[c2][4].x, cst[c2][4].y, cst[c2][4].z, cst[c2][4].w};
        float dcy[4], kp[4];
#pragma unroll
        for (int j = 0; j < 4; ++j) {
            const float z = -(w0c[j] + aw[c2][j]);
            const float w = -(fmaxf(z, 0.f) + __logf(1.f + __expf(-fabsf(z)))) - 0.5f;
            dcy[j] = __expf(-__expf(w));
            const float a = sigm(a0c[j] + aa[c2][j]);
            const float kk = kx[j] * kkc[j]; kp[j] = kx[j] * (1.f + (a - 1.f) * kac[j]);
            kkv[c2][j] = kk; av[c2][j] = a; pk2 += kk * kk; pb += rr[j] * kp[j] * rkc[j];
        }
        *(float4*)(RR + row * 256 + col0) = r4; *(float4*)(RWD + row * 256 + col0) = make_float4(dcy[0], dcy[1], dcy[2], dcy[3]);
        *(float4*)(RK + row * 256 + col0) = make_float4(kp[0], kp[1], kp[2], kp[3]); *(float4*)(RV + row * 256 + col0) = v4;
        *(float4*)(RG + row * 256 + col0) = make_float4(ag[c2][0], ag[c2][1], ag[c2][2], ag[c2][3]);
    }
    pk2 += __shfl_xor(pk2, 16); pk2 += __shfl_xor(pk2, 32); pb += __shfl_xor(pb, 16); pb += __shfl_xor(pb, 32);
    if (fq == 0) { part[tok * 8 + wave] = pk2; part[128 + tok * 8 + wave] = pb; }
    __syncthreads();
    {
        const float ssq = part[tok * 8 + (wave & 6)] + part[tok * 8 + (wave | 1)];
        const float inv = 1.f / fmaxf(sqrtf(ssq), 1e-12f);
#pragma unroll
        for (int c2 = 0; c2 < 2; ++c2) { const int col0 = wave * 32 + c2 * 16 + fq * 4;
            const float n0 = kkv[c2][0] * inv, n1 = kkv[c2][1] * inv, n2 = kkv[c2][2] * inv, n3 = kkv[c2][3] * inv;
            *(float4*)(RA + row * 256 + col0) = make_float4(-n0, -n1, -n2, -n3);
            *(float4*)(RB + row * 256 + col0) = make_float4(n0 * av[c2][0], n1 * av[c2][1], n2 * av[c2][2], n3 * av[c2][3]); }
        if ((wave & 1) == 0 && fq == 0) BON[row * 4 + (wave >> 1)] = part[128 + tok * 8 + wave] + part[128 + tok * 8 + wave + 1];
    }
    __syncthreads();
}

__device__ __forceinline__ void rwkv_item(const Ctx& p, int l, int sample, int b, int h, int rq, unsigned char* smem) {
    const int tid = launder_v(threadIdx.x), wave = tid >> 6, lane = tid & 63;
    const int T = sample ? 4 : 2048, CT = sample ? 4 : 32, nch = T / CT;
    const size_t rowg0 = sample ? (size_t)(16384 + b * 4) : (size_t)b * 2048;
    float* vec = (float*)smem;
    float* vb = vec + 2 * 5 * 32 * 64;
    float* yb = vb + 2 * 32 * 32;
    const float* arr[5] = {(const float*)(p.ws + O_RA), (const float*)(p.ws + O_RWD), (const float*)(p.ws + O_RK), (const float*)(p.ws + O_RB), (const float*)(p.ws + O_RR)};
    const float* RV = (const float*)(p.ws + O_RV); float* RY = (float*)(p.ws + O_RY);
    const bool loader = wave >= 4;
    const int lt = tid - 256;
    const int kq = lane & 15, rl0 = wave * 4 + (lane >> 4), rl1 = 16 + rl0, vrow0 = rq * 32 + rl0, vrow1 = rq * 32 + rl1;
    typedef float f32x2 __attribute__((ext_vector_type(2)));
    f32x2 A01 = {0.f, 0.f}, A23 = {0.f, 0.f}, B01 = {0.f, 0.f}, B23 = {0.f, 0.f};
    const int NB = sample ? 32 : 8;
    if (!loader && sample) { const float* sp = p.in(6) + (size_t)((l * 32 + b) * 4 + h) * 4096 + kq * 4;
        const float4 s0 = *(const float4*)(sp + vrow0 * 64), s1 = *(const float4*)(sp + vrow1 * 64);
        A01 = (f32x2){s0.x, s0.y}; A23 = (f32x2){s0.z, s0.w}; B01 = (f32x2){s1.x, s1.y}; B23 = (f32x2){s1.z, s1.w}; }
    float4 tA[10]; float4 vA;
    auto issue_chunk = [&](int c, float4 (&tmp)[10], float4& tv) {
        const size_t t0 = rowg0 + (size_t)c * CT;
#pragma unroll
        for (int a = 0; a < 5; ++a)
#pragma unroll
            for (int i = 0; i < 2; ++i) { const int idx = lt + i * 256, r = idx >> 4, c4 = idx & 15; tmp[a * 2 + i] = (r < CT) ? *(const float4*)(arr[a] + (t0 + r) * 256 + h * 64 + c4 * 4) : make_float4(0.f, 0.f, 0.f, 0.f); }
        { const int r = lt >> 3, c4 = lt & 7; tv = (r < CT) ? *(const float4*)(RV + (t0 + r) * 256 + h * 64 + rq * 32 + c4 * 4) : make_float4(0.f, 0.f, 0.f, 0.f); }
    };
    auto commit_chunk = [&](int c, const float4 (&tmp)[10], const float4& tv) {
        const int buf = c & 1;
#pragma unroll
        for (int a = 0; a < 5; ++a)
#pragma unroll
            for (int i = 0; i < 2; ++i) { const int idx = lt + i * 256; *(float4*)(vec + ((size_t)(buf * 5 + a) * 32) * 64 + idx * 4) = tmp[a * 2 + i]; }
        *(float4*)(vb + buf * 1024 + lt * 4) = tv;
    };
    auto flush_y = [&](int c) {
        const int buf = c & 1; const size_t t0 = rowg0 + (size_t)c * CT;
        const int r = lt >> 3, c4 = lt & 7; if (r < CT) *(float4*)(RY + (t0 + r) * 256 + h * 64 + rq * 32 + c4 * 4) = *(const float4*)(yb + buf * 1024 + lt * 4);
    };
    auto compute_chunk = [&](int c) {
        const int buf = c & 1;
        const float4* v4 = (const float4*)(vec + (size_t)buf * 5 * 32 * 64);
        const float* vbb = vb + buf * 1024; float* ybb = yb + buf * 1024;
        float* ydump = yb + 2048 + (tid & 255) * 2;
        const bool kb0 = (kq & 1) != 0, kb1 = (kq & 2) != 0;
        const int ystep = (kq & 1) * 2 + (kq >> 1);
        float* yq0 = (kq < 4) ? (ybb + ystep * 32 + rl0) : ydump;
        float* yq1 = (kq < 4) ? (ybb + ystep * 32 + rl1) : ydump + 1;
        float4 qa[4], qw[4], qk[4], qb[4], qr[4]; float qv0[4], qv1[4];
#pragma unroll
        for (int u = 0; u < 3; ++u) { const int tt = u < CT ? u : CT - 1; qa[u] = v4[(0 * 32 + tt) * 16 + kq]; qw[u] = v4[(1 * 32 + tt) * 16 + kq]; qk[u] = v4[(2 * 32 + tt) * 16 + kq]; qb[u] = v4[(3 * 32 + tt) * 16 + kq]; qr[u] = v4[(4 * 32 + tt) * 16 + kq];
            qv0[u] = vbb[tt * 32 + rl0]; qv1[u] = vbb[tt * 32 + rl1]; }
        for (int t0 = 0; t0 < CT; t0 += 4) {
            float ya[4], yc[4];
#pragma unroll
            for (int u = 0; u < 4; ++u) {
                { const int tn = (t0 + u + 3 < CT) ? t0 + u + 3 : CT - 1; const int sidx = (u + 3) & 3;
                    qa[sidx] = v4[(0 * 32 + tn) * 16 + kq]; qw[sidx] = v4[(1 * 32 + tn) * 16 + kq]; qk[sidx] = v4[(2 * 32 + tn) * 16 + kq]; qb[sidx] = v4[(3 * 32 + tn) * 16 + kq]; qr[sidx] = v4[(4 * 32 + tn) * 16 + kq];
                    qv0[sidx] = vbb[tn * 32 + rl0]; qv1[sidx] = vbb[tn * 32 + rl1]; }
                const f32x2 a01 = {qa[u].x, qa[u].y}, a23 = {qa[u].z, qa[u].w}, w01 = {qw[u].x, qw[u].y}, w23 = {qw[u].z, qw[u].w}, k01 = {qk[u].x, qk[u].y}, k23 = {qk[u].z, qk[u].w};
                const f32x2 b01 = {qb[u].x, qb[u].y}, b23 = {qb[u].z, qb[u].w}, r01 = {qr[u].x, qr[u].y}, r23 = {qr[u].z, qr[u].w};
                const f32x2 v0 = {qv0[u], qv0[u]}, v1 = {qv1[u], qv1[u]};
                const f32x2 tsa = A01 * a01 + A23 * a23, tsb = B01 * a01 + B23 * a23;
                const f32x2 pa01 = A01 * w01 + v0 * k01, pa23 = A23 * w23 + v0 * k23, pb01 = B01 * w01 + v1 * k01, pb23 = B23 * w23 + v1 * k23;
                float sa0 = tsa.x + tsa.y, sa1 = tsb.x + tsb.y;
                sa0 = red16_sum(sa0); sa1 = red16_sum(sa1);
                const f32x2 sv0 = {sa0, sa0}, sv1 = {sa1, sa1};
                A01 = pa01 + sv0 * b01; A23 = pa23 + sv0 * b23; B01 = pb01 + sv1 * b01; B23 = pb23 + sv1 * b23;
                const f32x2 tya = A01 * r01 + A23 * r23, tyb = B01 * r01 + B23 * r23;
                ya[u] = tya.x + tya.y; yc[u] = tyb.x + tyb.y;
            }
            { float u0 = kb0 ? ya[2] : ya[0], u1 = kb0 ? ya[3] : ya[1]; const float s0 = kb0 ? ya[0] : ya[2], s1 = kb0 ? ya[1] : ya[3];
                u0 += dppf<0xB1>(s0); u1 += dppf<0xB1>(s1);
                float vq = kb1 ? u1 : u0; const float sq = kb1 ? u0 : u1;
                vq += dppf<0x4E>(sq); vq += dppf<0x124>(vq); vq += dppf<0x128>(vq);
                yq0[t0 * 32] = vq; }
            { float u0 = kb0 ? yc[2] : yc[0], u1 = kb0 ? yc[3] : yc[1]; const float s0 = kb0 ? yc[0] : yc[2], s1 = kb0 ? yc[1] : yc[3];
                u0 += dppf<0xB1>(s0); u1 += dppf<0xB1>(s1);
                float vq = kb1 ? u1 : u0; const float sq = kb1 ? u0 : u1;
                vq += dppf<0x4E>(sq); vq += dppf<0x124>(vq); vq += dppf<0x128>(vq);
                yq1[t0 * 32] = vq; }
        }
    };
    if (loader) { issue_chunk(0, tA, vA); commit_chunk(0, tA, vA); if (nch > 1) issue_chunk(1, tA, vA); }
    __syncthreads();
    for (int c = 0; c < nch; ++c) {
        if (loader) { if (c + 1 < nch) { commit_chunk(c + 1, tA, vA); if (c + 2 < nch) issue_chunk(c + 2, tA, vA); } if (c > 0) flush_y(c - 1); }
        else compute_chunk(c);
        __syncthreads();
    }
    if (loader) flush_y(nch - 1);
    else { float* so = p.out + (sample ? OUT_SRWKV : OUT_PRWKV) + (size_t)((l * NB + b) * 4 + h) * 4096 + kq * 4;
        *(float4*)(so + vrow0 * 64) = make_float4(A01.x, A01.y, A23.x, A23.y); *(float4*)(so + vrow1 * 64) = make_float4(B01.x, B01.y, B23.x, B23.y); }
    __syncthreads();
}

__device__ __forceinline__ void gla_chunk(const Ctx& p, int l, int mode, int sample, int b, int h, int c, unsigned char* smem) {
    const int tid = launder_v(threadIdx.x), wave = tid >> 6, lane = tid & 63, fr = lane & 15, fq = lane >> 4;
    const int CL = sample ? 4 : 64, nch = sample ? 1 : 32, NB = sample ? 32 : 8;
    const size_t r0 = (sample ? (size_t)(16384 + b * 4) : (size_t)b * 2048) + (size_t)c * CL;
    bf16_t* qe = (bf16_t*)smem;
    bf16_t* ke = qe + 64 * 40;
    bf16_t* kdT = ke + 64 * 40;
    bf16_t* vT = kdT + 32 * 72;
    bf16_t* att = vT + 64 * 72;
    bf16_t* ST = att + 64 * 72;
    float* qf = (float*)(smem + 38400);
    float* kf = qf + 64 * 33;
    float* la = kf + 64 * 33;
    float* bc = la + 64 * 33;
    float* alr = bc + 64 * 33;
    float* w2s = alr + 64 * 17;
    float* bal = w2s + 512;
    float* dec = bal + 32;
    float* Sf = dec + 32;
    float* of = Sf + 2048;
    const bf16_t* COLS = (const bf16_t*)(p.ws + O_COLS);
    bf16_t* MIX = (bf16_t*)(p.ws + O_MIX);
    float* GINC = (float*)(p.ws + O_GINC); float* GDEC = (float*)(p.ws + O_GDEC);
    const int cbase = (b * 4 + h) * 32;
    w2s[tid] = p.in(14)[(size_t)l * 16 * 128 + (tid >> 5) * 128 + h * 32 + (tid & 31)];
    if (tid < 32) bal[tid] = p.in(15)[l * 128 + h * 32 + tid];
    if (mode == 1) {
        float4 S4;
        if (sample) S4 = *(const float4*)(p.in(5) + (size_t)((l * 32 + b) * 4 + h) * 2048 + tid * 4);
        else { S4 = make_float4(0.f, 0.f, 0.f, 0.f); const int kk = tid >> 4;
#pragma unroll 8
            for (int cp = 0; cp < c; ++cp) { const float4 inc = *(const float4*)(GINC + (size_t)(cbase + cp) * 2048 + tid * 4); const float dcy = GDEC[(cbase + cp) * 32 + kk];
                S4.x = dcy * S4.x + inc.x; S4.y = dcy * S4.y + inc.y; S4.z = dcy * S4.z + inc.z; S4.w = dcy * S4.w + inc.w; } }
        *(float4*)(Sf + tid * 4) = S4;
    }
    { uint4 qk = make_uint4(0, 0, 0, 0), vw = qk, al = qk;
        const int tq = (tid & 255) >> 2, pq = tid & 3, isk = tid >> 8, tv = tid >> 3, pvv = tid & 7, ta = tid >> 1, pa = tid & 1;
        if (tq < CL) qk = *(const uint4*)(COLS + (r0 + tq) * NINP + C_GLA + isk * 128 + h * 32 + pq * 8);
        if (tv < CL) vw = *(const uint4*)(COLS + (r0 + tv) * NINP + C_GLA + 256 + h * 64 + pvv * 8);
        if (tid < 128 && ta < CL) al = *(const uint4*)(COLS + (r0 + ta) * NINP + C_GLA + 512 + pa * 8);
        float* qkd = (isk ? kf : qf) + tq * 33 + pq * 8;
        const unsigned w0[4] = {qk.x, qk.y, qk.z, qk.w}, w1[4] = {vw.x, vw.y, vw.z, vw.w}, w2[4] = {al.x, al.y, al.z, al.w};
#pragma unroll
        for (int k = 0; k < 4; ++k) { qkd[2 * k] = __uint_as_float(w0[k] << 16); qkd[2 * k + 1] = __uint_as_float(w0[k] & 0xffff0000u);
            vT[(pvv * 8 + 2 * k) * 72 + tv] = (bf16_t)(w1[k] & 0xffffu); vT[(pvv * 8 + 2 * k + 1) * 72 + tv] = (bf16_t)(w1[k] >> 16); }
        if (tid < 128) {
#pragma unroll
            for (int k = 0; k < 4; ++k) { alr[ta * 17 + pa * 8 + 2 * k] = __uint_as_float(w2[k] << 16); alr[ta * 17 + pa * 8 + 2 * k + 1] = __uint_as_float(w2[k] & 0xffff0000u); } }
    }
    __syncthreads();
    for (int i = tid; i < 2048; i += 512) { const int t = i >> 5, kk = i & 31; float x = bal[kk];
#pragma unroll
        for (int rr = 0; rr < 16; ++rr) x += alr[t * 17 + rr] * w2s[rr * 32 + kk];
        const float ls = fminf(x, 0.f) - __logf(1.f + __expf(-fabsf(x)));
        la[t * 33 + kk] = t < CL ? ls * (1.f / 16.f) : 0.f; }
    __syncthreads();
    { const int kk = tid & 31, tg = tid >> 5;
        float pl[4]; float run = 0.f;
#pragma unroll
        for (int i = 0; i < 4; ++i) { run += la[(tg * 4 + i) * 33 + kk]; pl[i] = run; }
        of[tg * 33 + kk] = run;
        __syncthreads();
        float base = 0.f;
#pragma unroll
        for (int g = 0; g < 16; ++g) { const float x = of[g * 33 + kk]; base += g < tg ? x : 0.f; }
#pragma unroll
        for (int i = 0; i < 4; ++i) bc[(tg * 4 + i) * 33 + kk] = base + pl[i];
    }
    __syncthreads();
    for (int i = tid; i < 2048; i += 512) { const int t = i >> 5, kk = i & 31; const float bb = bc[t * 33 + kk], bl = bc[(CL - 1) * 33 + kk], q = qf[t * 33 + kk], k = kf[t * 33 + kk];
        qe[t * 40 + kk] = f2bf(q * __expf(bb) * 0.17677669529663687f); ke[t * 40 + kk] = f2bf(k * __expf(-bb)); kdT[kk * 72 + t] = t < CL ? f2bf(k * __expf(bl - bb)) : (bf16_t)0; }
    if (tid < 32) dec[tid] = __expf(bc[(CL - 1) * 33 + tid]);
    if (mode == 1) for (int i = tid; i < 2048; i += 512) { const int kk = i >> 6, v = i & 63; ST[v * 40 + kk] = f2bf(Sf[i]); }
    __syncthreads();
    const bool need_inc = (mode == 0) || (c == nch - 1);
    if (mode == 1) {
        for (int ti = wave * 2; ti < wave * 2 + 2; ++ti) {
            const int tt = ti >> 2, st = ti & 3; f32x4 acc = {0.f, 0.f, 0.f, 0.f};
            if (st <= tt) acc = mma16(ldfrag(qe, 40, tt * 16, 0, lane), ldfrag(ke, 40, st * 16, 0, lane), acc);
#pragma unroll
            for (int j = 0; j < 4; ++j) { const int t = tt * 16 + fq * 4 + j, s = st * 16 + fr; att[t * 72 + s] = f2bf(s <= t ? acc[j] : 0.f); }
        }
        __syncthreads();
        for (int ti = wave * 2; ti < wave * 2 + 2; ++ti) {
            const int tt = ti >> 2, vt = ti & 3; f32x4 acc = {0.f, 0.f, 0.f, 0.f};
#pragma unroll
            for (int ks = 0; ks < 2; ++ks) acc = mma16(ldfrag(att, 72, tt * 16, ks * 32, lane), ldfrag(vT, 72, vt * 16, ks * 32, lane), acc);
            acc = mma16(ldfrag(qe, 40, tt * 16, 0, lane), ldfrag(ST, 40, vt * 16, 0, lane), acc);
#pragma unroll
            for (int j = 0; j < 4; ++j) of[(tt * 16 + fq * 4 + j) * 65 + vt * 16 + fr] = acc[j];
        }
    }
    if (need_inc) { const int kt = wave >> 2, vt = wave & 3; f32x4 acc = {0.f, 0.f, 0.f, 0.f};
#pragma unroll
        for (int ks = 0; ks < 2; ++ks) acc = mma16(ldfrag(kdT, 72, kt * 16, ks * 32, lane), ldfrag(vT, 72, vt * 16, ks * 32, lane), acc);
#pragma unroll
        for (int j = 0; j < 4; ++j) { const int kk = kt * 16 + fq * 4 + j, v = vt * 16 + fr;
            if (mode == 0) { GINC[(size_t)(cbase + c) * 2048 + kk * 64 + v] = acc[j]; }
            else { float* so = p.out + (sample ? OUT_SGLA : OUT_PGLA) + (size_t)((l * NB + b) * 4 + h) * 2048; so[kk * 64 + v] = dec[kk] * Sf[kk * 64 + v] + acc[j]; } }
        if (mode == 0 && tid < 32) GDEC[(cbase + c) * 32 + tid] = dec[tid];
    }
    __syncthreads();
    if (mode == 1) { const int t = tid >> 3, part = tid & 7; float ov[8]; float ss = 0.f;
#pragma unroll
        for (int i = 0; i < 8; ++i) { ov[i] = of[t * 65 + part * 8 + i]; ss += ov[i] * ov[i]; }
        ss = red8_sum(ss);
        const float rs = rsqrtf(ss * (1.f / 64.f) + EPS);
        if (t < CL) { const bf16_t* gp = COLS + (r0 + t) * NINP + C_GLA + 528 + h * 64 + part * 8; const float* gn = p.in(16) + l * 256 + h * 64 + part * 8;
            float o[8];
#pragma unroll
            for (int i = 0; i < 8; ++i) o[i] = ov[i] * rs * gn[i] * silu_f(bf2f(gp[i]));
            uint4 w; w.x = pack2(o[0], o[1]); w.y = pack2(o[2], o[3]); w.z = pack2(o[4], o[5]); w.w = pack2(o[6], o[7]);
            *(uint4*)(MIX + (r0 + t) * 1024 + h * 64 + part * 8) = w; }
        __syncthreads();
    }
}

__device__ __forceinline__ void phase_mixer_pre(const Ctx& p0, int l0, unsigned char* smem) {
    for (int item0 = blockIdx.x; item0 < 1032 + 1024 + DUP_PRE_N; item0 += gridDim.x) {
        const Ctx p{p0.tab, launder_p(p0.out), launder_p(p0.ws)}; const int l = launder_s(l0);
        int item = item0;
#if DUP_PRE == 1
        if (item >= 2056) item -= 2056;
#elif DUP_PRE == 2
        if (item >= 2056) item = item - 2056 + 1032;
#endif
        if (item < 1032) rwkv_pre_item(p, l, item, smem);
        else { const int u = item - 1032; gla_chunk(p, l, 0, 0, u >> 7, (u >> 5) & 3, u & 31, smem); }
    }
}

__device__ __forceinline__ void gmlp_prompt_item(const Ctx& p, int l, int id, unsigned char* smem) {
    const int tid = launder_v(threadIdx.x), wave = tid >> 6, lane = tid & 63, fr = lane & 15, fq = lane >> 4;
    const size_t r0 = (size_t)(id >> 4) * 2048 + (size_t)(id & 15) * 128;
    bf16_t* vnT = (bf16_t*)smem;
    bf16_t* Wb = vnT + 256 * 136;
    const bf16_t* COLS = (const bf16_t*)(p.ws + O_COLS);
    bf16_t* MIX = (bf16_t*)(p.ws + O_MIX);
    for (int hf = 0; hf < 4; ++hf) { const int t = hf * 32 + (tid >> 4), part = tid & 15;
        const uint4* src = (const uint4*)(COLS + (r0 + t) * NINP + C_GMLP + 256 + part * 16);
        float x[16]; float s = 0.f;
#pragma unroll
        for (int i = 0; i < 2; ++i) { const uint4 w = src[i]; const unsigned ww[4] = {w.x, w.y, w.z, w.w};
#pragma unroll
            for (int k = 0; k < 4; ++k) { x[i * 8 + k * 2] = gelu_e(__uint_as_float(ww[k] << 16)); x[i * 8 + k * 2 + 1] = gelu_e(__uint_as_float(ww[k] & 0xffff0000u)); } }
#pragma unroll
        for (int i = 0; i < 16; ++i) s += x[i];
        s = red16_sum(s);
        const float mean = s * (1.f / 256.f); float q = 0.f;
#pragma unroll
        for (int i = 0; i < 16; ++i) { const float d = x[i] - mean; q += d * d; }
        q = red16_sum(q);
        const float rstd = rsqrtf(q * (1.f / 256.f) + 1e-5f);
        const float* lg = p.in(17) + l * 256 + part * 16; const float* lb = p.in(18) + l * 256 + part * 16;
#pragma unroll
        for (int i = 0; i < 16; ++i) vnT[(part * 16 + i) * 136 + t] = f2bf((x[i] - mean) * rstd * lg[i] + lb[i]);
    }
    for (int g = 0; g < 4; ++g) {
        const float* W = p.in(19) + (size_t)(l * 4 + g) * 128 * 128;
        const float* bs = p.in(20) + (size_t)(l * 4 + g) * 128;
        const int tt = wave;
        float4 wv[8]; bf16_t uraw[4][4]; float bsv[4];
#pragma unroll
        for (int i = 0; i < 8; ++i) wv[i] = *(const float4*)(W + (size_t)(tid + i * 512) * 4);
#pragma unroll
        for (int j = 0; j < 4; ++j) { const int t = tt * 16 + fq * 4 + j; bsv[j] = bs[t];
#pragma unroll
            for (int ct = 0; ct < 4; ++ct) uraw[j][ct] = COLS[(r0 + t) * NINP + C_GMLP + g * 64 + ct * 16 + fr]; }
#pragma unroll
        for (int i = 0; i < 8; ++i) { const int idx4 = tid + i * 512, t = idx4 >> 5, s4 = (idx4 & 31) * 4;
            uint2 o; o.x = pack2(s4 <= t ? wv[i].x : 0.f, s4 + 1 <= t ? wv[i].y : 0.f); o.y = pack2(s4 + 2 <= t ? wv[i].z : 0.f, s4 + 3 <= t ? wv[i].w : 0.f);
            *(uint2*)(Wb + t * 136 + s4) = o; }
        __syncthreads();
        f32x4 acc[4];
#pragma unroll
        for (int ct = 0; ct < 4; ++ct) acc[ct] = (f32x4){0.f, 0.f, 0.f, 0.f};
#pragma unroll
        for (int ks = 0; ks < 4; ++ks) { const bf16x8 a = ldfrag(Wb, 136, tt * 16, ks * 32, lane);
#pragma unroll
            for (int ct = 0; ct < 4; ++ct) acc[ct] = mma16(a, ldfrag(vnT, 136, g * 64 + ct * 16, ks * 32, lane), acc[ct]); }
#pragma unroll
        for (int j = 0; j < 4; ++j) { const int t = tt * 16 + fq * 4 + j;
#pragma unroll
            for (int ct = 0; ct < 4; ++ct) { const int c = g * 64 + ct * 16 + fr; const float u = gelu_e(bf2f(uraw[j][ct])); MIX[(r0 + t) * 1024 + 256 + c] = f2bf(u * (acc[ct][j] + bsv[j])); } }
        __syncthreads();
    }
}

__device__ __forceinline__ void gmlp_sample_item(const Ctx& p, int l, int b, unsigned char* smem) {
    const int tid = launder_v(threadIdx.x), wave = tid >> 6, lane = tid & 63;
    const size_t r0 = (size_t)(16384 + b * 4);
    float* vv = (float*)smem;
    const bf16_t* COLS = (const bf16_t*)(p.ws + O_COLS);
    bf16_t* MIX = (bf16_t*)(p.ws + O_MIX);
    for (int e = tid; e < 1024; e += 512) { const int t = e >> 8, c = e & 255; vv[e] = gelu_e(bf2f(COLS[(r0 + t) * NINP + C_GMLP + 256 + c])); }
    __syncthreads();
    if (wave < 4) { const int t = wave; float x[4]; float s = 0.f;
#pragma unroll
        for (int i = 0; i < 4; ++i) { x[i] = vv[t * 256 + lane + 64 * i]; s += x[i]; }
        s = wave_sum(s); const float mean = s * (1.f / 256.f); float q = 0.f;
#pragma unroll
        for (int i = 0; i < 4; ++i) { const float d = x[i] - mean; q += d * d; }
        q = wave_sum(q); const float rstd = rsqrtf(q * (1.f / 256.f) + 1e-5f);
#pragma unroll
        for (int i = 0; i < 4; ++i) { const int c = lane + 64 * i; const float vn = (x[i] - mean) * rstd * p.in(17)[l * 256 + c] + p.in(18)[l * 256 + c]; vv[t * 256 + c] = vn;
            p.out[OUT_SGV + ((size_t)(l * 32 + b) * 4 + t) * 256 + c] = vn; } }
    __syncthreads();
    for (int e = tid; e < 1024; e += 512) { const int t = e >> 8, c = e & 255, g = c >> 6;
        const float* W = p.in(19) + (size_t)(l * 4 + g) * 128 * 128 + t * 128;
        float s = p.in(20)[(size_t)(l * 4 + g) * 128 + t];
        for (int s_ = 0; s_ <= t; ++s_) s += W[s_] * vv[s_ * 256 + c];
        const float u = gelu_e(bf2f(COLS[(r0 + t) * NINP + C_GMLP + c]));
        MIX[(r0 + t) * 1024 + 256 + c] = f2bf(u * s); }
    __syncthreads();
}

__device__ __forceinline__ void dil_prompt_item(const Ctx& p, int l, int id, unsigned char* smem) {
    const int tid = launder_v(threadIdx.x), wave = tid >> 6, lane = tid & 63, fr = lane & 15, fq = lane >> 4;
    const int h = id & 3, qb = (id >> 2) & 15, gi = (id >> 6) % 3, b = id / 192;
    const int dsh = gi * 2, d = 1 << dsh, nbk = 16 >> dsh, r = qb / nbk, mb = qb % nbk;
    const bf16_t* cols = (const bf16_t*)(p.ws + O_COLS) + (size_t)(b * 2048) * NINP + C_DIL + gi * 768 + h * 64;
    bf16_t* Ks = (bf16_t*)smem;
    bf16_t* Qs = Ks + 256 * 72;
    bf16_t* Vt = Qs + 128 * 72;
    bf16_t* Pw = (bf16_t*)smem + wave * 16 * 168;
    bf16_t* DILO = (bf16_t*)(p.ws + O_DILO); float* LSE = (float*)(p.ws + O_LSE);
    { const int row = tid >> 1, half = tid & 1, mk = mb * 128 - 128 + row;
        uint4 v0 = make_uint4(0, 0, 0, 0), v1 = v0, v2 = v0, v3 = v0;
        if (mk >= 0) { const uint4* s = (const uint4*)(cols + (size_t)(r + d * mk) * NINP + 256 + half * 32); v0 = s[0]; v1 = s[1]; v2 = s[2]; v3 = s[3]; }
        uint4* dp = (uint4*)(Ks + row * 72 + half * 32); dp[0] = v0; dp[1] = v1; dp[2] = v2; dp[3] = v3; }
    { const int key = tid & 255, dh = tid >> 8, mk = mb * 128 - 128 + key;
        uint4 v[4]; v[0] = make_uint4(0, 0, 0, 0); v[1] = v[0]; v[2] = v[0]; v[3] = v[0];
        if (mk >= 0) { const uint4* s = (const uint4*)(cols + (size_t)(r + d * mk) * NINP + 512 + dh * 32); v[0] = s[0]; v[1] = s[1]; v[2] = s[2]; v[3] = s[3]; }
#pragma unroll
        for (int i = 0; i < 4; ++i) { const unsigned ww[4] = {v[i].x, v[i].y, v[i].z, v[i].w};
#pragma unroll
            for (int k = 0; k < 4; ++k) { Vt[(dh * 32 + i * 8 + k * 2) * 280 + key] = (bf16_t)(ww[k] & 0xffffu); Vt[(dh * 32 + i * 8 + k * 2 + 1) * 280 + key] = (bf16_t)(ww[k] >> 16); } } }
    for (int idx = tid; idx < 64 * 24; idx += 512) Vt[(idx / 24) * 280 + 256 + idx % 24] = 0;
    { const int row = tid >> 2, qt = tid & 3, m = mb * 128 + row;
        const uint4* s = (const uint4*)(cols + (size_t)(r + d * m) * NINP + qt * 16);
        uint4* dp = (uint4*)(Qs + row * 72 + qt * 16); dp[0] = s[0]; dp[1] = s[1]; }
    __syncthreads();
    const int q0 = wave * 16, kx0 = wave * 16;
    f32x4 acc[9];
    { const bf16x8 a0 = ldfrag(Qs, 72, q0, 0, lane), a1 = ldfrag(Qs, 72, q0, 32, lane);
#pragma unroll
        for (int t = 0; t < 9; ++t) { acc[t] = (f32x4){0.f, 0.f, 0.f, 0.f};
            acc[t] = mma16(a0, ldfrag(Ks, 72, kx0 + t * 16, 0, lane), acc[t]); acc[t] = mma16(a1, ldfrag(Ks, 72, kx0 + t * 16, 32, lane), acc[t]); } }
    const float slope = exp2f(-8.f * (float)(gi * 4 + h + 1) / 12.f) * (float)d;
    float mx[4] = {-1e30f, -1e30f, -1e30f, -1e30f}, den[4] = {0.f, 0.f, 0.f, 0.f};
#pragma unroll
    for (int t = 0; t < 9; ++t)
#pragma unroll
        for (int j = 0; j < 4; ++j) { const int qi = q0 + fq * 4 + j, kx = kx0 + t * 16 + fr, dist = qi + 128 - kx;
            const bool valid = dist >= 0 && dist <= 128 && (mb * 128 - 128 + kx) >= 0;
            const float s = valid ? acc[t][j] * 0.125f - slope * (float)dist : -1e30f; acc[t][j] = s; mx[j] = fmaxf(mx[j], s); }
#pragma unroll
    for (int j = 0; j < 4; ++j) mx[j] = red16_max(mx[j]);
#pragma unroll
    for (int t = 0; t < 9; ++t)
#pragma unroll
        for (int j = 0; j < 4; ++j) { const float pv = acc[t][j] > -1e29f ? __expf(acc[t][j] - mx[j]) : 0.f; acc[t][j] = pv; den[j] += pv; }
#pragma unroll
    for (int j = 0; j < 4; ++j) den[j] = red16_sum(den[j]);
    __syncthreads();
#pragma unroll
    for (int t = 0; t < 9; ++t)
#pragma unroll
        for (int j = 0; j < 4; ++j) Pw[(fq * 4 + j) * 168 + t * 16 + fr] = f2bf(acc[t][j]);
    for (int i = lane; i < 16 * 24; i += 64) Pw[(i / 24) * 168 + 144 + i % 24] = 0;
    __syncthreads();
    f32x4 o[4];
#pragma unroll
    for (int dt = 0; dt < 4; ++dt) o[dt] = (f32x4){0.f, 0.f, 0.f, 0.f};
#pragma unroll
    for (int kk = 0; kk < 5; ++kk) { const bf16x8 pa = *(const bf16x8*)(Pw + fr * 168 + kk * 32 + fq * 8);
#pragma unroll
        for (int dt = 0; dt < 4; ++dt) { const bf16x8 vb = *(const bf16x8*)(Vt + (dt * 16 + fr) * 280 + kx0 + kk * 32 + fq * 8); o[dt] = mma16(pa, vb, o[dt]); } }
#pragma unroll
    for (int j = 0; j < 4; ++j) { const int qi = q0 + fq * 4 + j, m = mb * 128 + qi; const size_t rowg = (size_t)b * 2048 + r + d * m; const float inv = 1.f / den[j];
#pragma unroll
        for (int dt = 0; dt < 4; ++dt) DILO[((size_t)gi * MR + rowg) * 256 + h * 64 + dt * 16 + fr] = f2bf(o[dt][j] * inv);
        if (fr == 0) LSE[((size_t)gi * MR + rowg) * 4 + h] = mx[j] + __logf(den[j]); }
    __syncthreads();
}

__device__ __forceinline__ float4 dil_row(const float* cache, const bf16_t* COLS, int l, int b, size_t r0, int gi, int i, int j, int kv, int lane) {
    const int L = gi == 0 ? 128 : (gi == 1 ? 512 : 2048), rel = i - (j << (gi * 2));
    const int relc = rel >= 0 ? rel : 0, rowc = rel < 0 ? L + rel : 0;
    const uint2 w = *(const uint2*)(COLS + (r0 + relc) * NINP + C_DIL + gi * 768 + 256 + kv * 256 + lane * 4);
    const float4 c = *(const float4*)(cache + (((size_t)(l * 32 + b) * L + rowc) * 2 + kv) * 256 + lane * 4);
    const float4 n = make_float4(__uint_as_float(w.x << 16), __uint_as_float(w.x & 0xffff0000u), __uint_as_float(w.y << 16), __uint_as_float(w.y & 0xffff0000u));
    return rel >= 0 ? n : c;
}
__device__ __forceinline__ void dil_sample_item(const Ctx& p, int l, int b, int gi, unsigned char* smem) {
    const int tid = launder_v(threadIdx.x), wave = tid >> 6, lane = tid & 63;
    const size_t r0 = (size_t)(16384 + b * 4);
    float* qs = (float*)smem;
    float* sc = qs + 4 * 256;
    float* mden = sc + 16 * 132;
    float* part = mden + 32;
    const bf16_t* COLS = (const bf16_t*)(p.ws + O_COLS);
    bf16_t* DILO = (bf16_t*)(p.ws + O_DILO); float* LSE = (float*)(p.ws + O_LSE);
    const float* cache = p.in(2 + gi);
    for (int e = tid; e < 1024; e += 512) { const int i = e >> 8, hc = e & 255; qs[e] = bf2f(COLS[(r0 + i) * NINP + C_DIL + gi * 768 + hc]); }
    __syncthreads();
    const int h = lane >> 4;
    const float slope = exp2f(-8.f * (float)(gi * 4 + h + 1) / 12.f);
#pragma unroll 8
    for (int r = wave; r < 516; r += 8) {
        const int i = r / 129, j = r % 129;
        const float4 k4 = dil_row(cache, COLS, l, b, r0, gi, i, j, 0, lane);
        const float4 q4 = *(const float4*)(qs + i * 256 + lane * 4);
        float dot = q4.x * k4.x + q4.y * k4.y + q4.z * k4.z + q4.w * k4.w;
        dot = red16_sum(dot);
        if ((lane & 15) == 0) sc[(i * 4 + h) * 132 + j] = dot * 0.125f - slope * (float)(j << (gi * 2));
    }
    __syncthreads();
    for (int combo = wave; combo < 16; combo += 8) {
        float s0 = sc[combo * 132 + lane], s1 = sc[combo * 132 + 64 + lane], s2 = lane == 0 ? sc[combo * 132 + 128] : -1e30f;
        const float m = wave_max(fmaxf(fmaxf(s0, s1), s2));
        const float p0 = __expf(s0 - m), p1 = __expf(s1 - m), p2 = lane == 0 ? __expf(s2 - m) : 0.f;
        const float dn = wave_sum(p0 + p1 + p2);
        sc[combo * 132 + lane] = p0; sc[combo * 132 + 64 + lane] = p1; if (lane == 0) { sc[combo * 132 + 128] = p2; mden[combo * 2] = m; mden[combo * 2 + 1] = dn; }
    }
    __syncthreads();
    { const int i = wave >> 1, j0 = (wave & 1) * 65, j1 = (wave & 1) ? 129 : 65, combo = i * 4 + h;
        float4 acc = make_float4(0.f, 0.f, 0.f, 0.f);
#pragma unroll 13
        for (int j = j0; j < j1; ++j) { const float4 v4 = dil_row(cache, COLS, l, b, r0, gi, i, j, 1, lane); const float pj = sc[combo * 132 + j];
            acc.x += pj * v4.x; acc.y += pj * v4.y; acc.z += pj * v4.z; acc.w += pj * v4.w; }
        *(float4*)(part + wave * 256 + lane * 4) = acc; }
    __syncthreads();
    for (int e = tid; e < 1024; e += 512) { const int i = e >> 8, c = e & 255, hh = c >> 6, combo = i * 4 + hh;
        const float v = (part[(2 * i) * 256 + c] + part[(2 * i + 1) * 256 + c]) / mden[combo * 2 + 1];
        DILO[((size_t)gi * MR + r0 + i) * 256 + c] = f2bf(v);
        if ((c & 63) == 0) LSE[((size_t)gi * MR + r0 + i) * 4 + hh] = mden[combo * 2] + __logf(mden[combo * 2 + 1]); }
    __syncthreads();
}

__device__ __forceinline__ void phase_mixer_main(const Ctx& p0, int ci, int l0, unsigned char* smem) {
    unsigned* ctr = (unsigned*)(p0.ws + O_CTR) + ci;
    __shared__ int s_item;
    int nxt = 0;
    const bool lead = threadIdx.x == 0;
    if (lead) nxt = (int)atomicAdd(ctr, 1u);
    for (;;) {
        if (lead) s_item = nxt;
        __syncthreads();
        int it = s_item;
        __syncthreads();
        if (lead) nxt = (int)atomicAdd(ctr, 1u);
#if DUP_SMALL == 1
        if (it >= 128 + 2 * 3392) break;
        if (it >= 3520) it -= 3392;
#elif DUP_SMALL == 2
        if (it >= 3520 + 1024) break;
        if (it >= 3520) it = it - 3520 + 160;
#elif DUP_SMALL == 4
        if (it >= 3520 + 800) break;
        if (it >= 3520) it = it - 3520 + 2720;
#elif DUP_SMALL == 5
        if (it >= 3520 + 32) break;
        if (it >= 3520) it = it - 3520 + 128;
#elif DUP_SMALL == 3
        if (it >= 3520 + 1536) break;
        if (it >= 3520) it = it - 3520 + 1184;
#else
        if (it >= 3264) break;
#endif
        const Ctx p{p0.tab, launder_p(p0.out), launder_p(p0.ws)}; const int l = launder_s(l0);
        if (it < 64) rwkv_item(p, l, 0, it >> 3, (it >> 1) & 3, it & 1, smem);
        else if (it < 160) { const int u = it - 64; dil_sample_item(p, l, u / 3, u % 3, smem); }
        else if (it < 1184) { const int u = it - 160; gla_chunk(p, l, 1, 0, u >> 7, (u >> 5) & 3, u & 31, smem); }
        else if (it < 2720) dil_prompt_item(p, l, it - 1184, smem);
        else if (it < 2848) gmlp_prompt_item(p, l, it - 2720, smem);
        else if (it < 3104) { const int u = it - 2848; rwkv_item(p, l, 1, u >> 3, (u >> 1) & 3, u & 1, smem); }
        else if (it < 3232) { const int u = it - 3104; gla_chunk(p, l, 1, 1, u >> 2, u & 3, 0, smem); }
        else gmlp_sample_item(p, l, it - 3232, smem);
    }
}

__device__ __forceinline__ void phase_mixer_post(const Ctx& p, int l) {
    const int tid = launder_v(threadIdx.x), wave = tid >> 6, lane = tid & 63;
    const float* RY = (const float*)(p.ws + O_RY); const float* RV = (const float*)(p.ws + O_RV); const float* RG = (const float*)(p.ws + O_RG); const float* BON = (const float*)(p.ws + O_BON);
    const bf16_t* DILO = (const bf16_t*)(p.ws + O_DILO); const float* LSE = (const float*)(p.ws + O_LSE);
    bf16_t* MIX = (bf16_t*)(p.ws + O_MIX);
    const float* lg = p.in(30) + l * 256; const float* lb = p.in(31) + l * 256;
    float lgv[4], lbv[4];
#pragma unroll
    for (int hh = 0; hh < 4; ++hh) { lgv[hh] = lg[hh * 64 + lane]; lbv[hh] = lb[hh * 64 + lane]; }
    const int step = gridDim.x * 8;
    float ny[4], nbon[4], nrv[4], nrg[4], nls[3][4]; bf16_t ndl[3][4];
    auto load_row = [&](int row) {
#pragma unroll
        for (int hh = 0; hh < 4; ++hh) {
            const int ch = hh * 64 + lane;
            ny[hh] = RY[(size_t)row * 256 + ch]; nbon[hh] = BON[(size_t)row * 4 + hh]; nrv[hh] = RV[(size_t)row * 256 + ch]; nrg[hh] = RG[(size_t)row * 256 + ch];
#pragma unroll
            for (int gi = 0; gi < 3; ++gi) { nls[gi][hh] = LSE[((size_t)gi * MR + row) * 4 + hh]; ndl[gi][hh] = DILO[((size_t)gi * MR + row) * 256 + ch]; }
        }
    };
    int row = blockIdx.x * 8 + wave;
    if (row < MR) load_row(row);
    for (; row < MR; row += step) {
        float y[4], bon[4], rv[4], rg[4], ls[3][4]; bf16_t dl[3][4];
#pragma unroll
        for (int hh = 0; hh < 4; ++hh) { y[hh] = ny[hh]; bon[hh] = nbon[hh]; rv[hh] = nrv[hh]; rg[hh] = nrg[hh];
#pragma unroll
            for (int gi = 0; gi < 3; ++gi) { ls[gi][hh] = nls[gi][hh]; dl[gi][hh] = ndl[gi][hh]; } }
        float mean[4];
#pragma unroll
        for (int hh = 0; hh < 4; ++hh) mean[hh] = wave_sum(y[hh]) * (1.f / 64.f);
        if (row + step < MR) load_row(row + step);
#pragma unroll
        for (int hh = 0; hh < 4; ++hh) {
            const int ch = hh * 64 + lane;
            const float dv = y[hh] - mean[hh];
            const float var = wave_sum(dv * dv) * (1.f / 64.f);
            const float yn = dv * rsqrtf(var + 64e-5f) * lgv[hh] + lbv[hh];
            const float o = (yn + bon[hh] * rv[hh]) * rg[hh];
            MIX[(size_t)row * 1024 + 512 + ch] = f2bf(o);
            const float l0 = ls[0][hh], l1 = ls[1][hh], l2 = ls[2][hh];
            const float mx = fmaxf(l0, fmaxf(l1, l2));
            const float e0 = __expf(l0 - mx), e1 = __expf(l1 - mx), e2 = __expf(l2 - mx), inv = 1.f / (e0 + e1 + e2);
            const float od = (e0 * bf2f(dl[0][hh]) + e1 * bf2f(dl[1][hh]) + e2 * bf2f(dl[2][hh])) * inv;
            MIX[(size_t)row * 1024 + 768 + ch] = f2bf(od);
        }
    }
}

__global__ __launch_bounds__(512, 2) void mega(Params pk) {
    extern __shared__ __attribute__((aligned(16))) unsigned char smem[];
    __shared__ gfptr_t s_in[32];
    __shared__ uint4 xb_words;
    cg::grid_group grid = cg::this_grid();
    if (threadIdx.x == 0) { xb_words = make_uint4(0u, 0u, 0u, 0u);
#pragma unroll
        for (int i = 0; i < 32; ++i) s_in[i] = (gfptr_t)pk.in[i];
    }
    __syncthreads();
    const XcdBarrier xb = xcd_barrier_post((unsigned*)(pk.ws + O_BAR), (volatile LAS unsigned*)&xb_words);
    if (pk.ph_hi == 0x7fffffff) grid.sync();
    for (int si = pk.ph_lo; si < pk.ph_hi; ++si) {
        const int jj = si < 0 ? 12 : si % 12;
        const int reps = (((REPMASK >> jj) & 1) && (jj != 2 || si == 2)) ? 2 : 1;
        for (int rep = 0; rep < reps; ++rep) {
        const Ctx p{s_in, launder_p(pk.out), launder_p(pk.ws)};
#if TPROBE
        const unsigned long long tp0 = __builtin_amdgcn_s_memrealtime();
#endif
        if (si < 0) phase_prologue(p, smem);
        else {
            const int l = si / 12, j = si % 12;
            if (j == 0 || j == 9) {
                const int blk = l * 2 + (j == 9);
                pg8::Gemm g{(const bf16_t*)(p.ws + O_XN), (const bf16_t*)(p.ws + O_WGU + blk * SZ_WGU1), MPAD, 5632, 1024};
                pg8::StaticOrder S; S.init(g.M, g.N, (int)gridDim.x, (int)blockIdx.x);
                EpiSwiGLU E{(bf16_t*)(p.ws + O_ACT)};
                pg8::gemm_phase<EpiSwiGLU, pg8::StaticOrder, false>((PG8_LAS unsigned char*)smem, g, S, E, nullptr);
            } else if (j == 1 || j == 10 || j == 7) {
                const bf16_t* A; const bf16_t* Bt; int K;
                if (j == 7) { A = (const bf16_t*)(p.ws + O_MIX); Bt = (const bf16_t*)(p.ws + O_WOUT + l * SZ_WOUT1); K = 1024; }
                else { A = (const bf16_t*)(p.ws + O_ACT); Bt = (const bf16_t*)(p.ws + O_WD + (l * 2 + (j == 10)) * SZ_WD1); K = 2816; }
                pg8::Gemm g{A, Bt, 16384, 1024, K};
                pg8::StaticOrder S; S.init(g.M, g.N, (int)gridDim.x, (int)blockIdx.x);
                EpiBf16SS E{(bf16_t*)(p.ws + O_F), (float*)(p.ws + O_SSP)};
                pg8::gemm_phase<EpiBf16SS, pg8::StaticOrder, false>((PG8_LAS unsigned char*)smem, g, S, E, nullptr);
                __syncthreads();
                tail_gemm(A, Bt, K, (bf16_t*)(p.ws + O_F), (float*)(p.ws + O_SSPT), smem);
            } else if (j == 2 || j == 8 || j == 11) {
                phase_ew(p, l, j == 2 ? 0 : (j == 8 ? 1 : 2));
            } else if (j == 3) {
                pg8::Gemm g{(const bf16_t*)(p.ws + O_XN), (const bf16_t*)(p.ws + O_WIN + l * SZ_WIN1), MPAD, NINP, 1024};
                pg8::StaticOrder S; S.init(g.M, g.N, (int)gridDim.x, (int)blockIdx.x);
                EpiBf16P E{(bf16_t*)(p.ws + O_COLS), NINP};
                pg8::gemm_phase<EpiBf16P, pg8::StaticOrder, false>((PG8_LAS unsigned char*)smem, g, S, E, nullptr);
            } else if (j == 4) phase_mixer_pre(p, l, smem);
            else if (j == 5) {
#if SPLIT_MAIN
                for (int r5 = 0; r5 < SPLIT_MAIN; ++r5) { if (blockIdx.x < 64) rwkv_item(p, l, 0, blockIdx.x >> 3, (blockIdx.x >> 1) & 3, blockIdx.x & 1, smem); xcd_barrier(xb); }
#endif
                phase_mixer_main(p, l * 2 + rep, l, smem);
            }
            else phase_mixer_post(p, l);
        }
#if TPROBE
        if ((TPROBE >> jj) & 1) { const unsigned long long tp1 = __builtin_amdgcn_s_memrealtime(), tend = tp1 + 4ull * (tp1 - tp0); while (__builtin_amdgcn_s_memrealtime() < tend) __builtin_amdgcn_s_sleep(16); }
#endif
        if (rep + 1 < reps || si + 1 < pk.ph_hi) { xcd_barrier(xb);
#if EXTRA_SYNC
            for (int es = 0; es < EXTRA_SYNC; ++es) xcd_barrier(xb);
#endif
        }
        }
    }
}

#ifndef MK_LAUNCH_PER_PHASE
#define MK_LAUNCH_PER_PHASE 0
#endif
extern "C" void kernel_launch(void* const* d_in, const int* in_sizes, int n_in, void* d_out, int out_size, void* d_ws, size_t ws_size, hipStream_t stream) {
    static int grid = 0;
    if (grid == 0) {
        if (n_in != 32 || (size_t)out_size != OUT_END || ws_size < WS_END) { fprintf(stderr, "kernel_launch: unexpected shapes: n_in %d out %d ws %zu (need %zu)\n", n_in, out_size, ws_size, (size_t)WS_END); grid = -1; return; }
        int dev = 0, cus = 0, per_cu = 0;
        hipGetDevice(&dev); hipDeviceGetAttribute(&cus, hipDeviceAttributeMultiprocessorCount, dev);
        if (hipFuncSetAttribute((const void*)mega, hipFuncAttributeMaxDynamicSharedMemorySize, LDS_BYTES) != hipSuccess) { fprintf(stderr, "kernel_launch: hipFuncSetAttribute failed\n"); grid = -1; return; }
        if (hipOccupancyMaxActiveBlocksPerMultiprocessor(&per_cu, (const void*)mega, 512, LDS_BYTES) != hipSuccess || per_cu < 1) { fprintf(stderr, "kernel_launch: occupancy query says %d\n", per_cu); per_cu = 1; }
        (void)hipGetLastError();
        grid = cus * 1;
    }
    if (grid < 0) return;
    if (hipMemsetAsync((char*)d_ws + O_CTR, 0, 256 + 3456 * 4, stream) != hipSuccess) { fprintf(stderr, "kernel_launch: memset failed\n"); return; }
    Params p{};
    for (int i = 0; i < 32; ++i) p.in[i] = (const float*)d_in[i];
    p.out = (float*)d_out; p.ws = (unsigned char*)d_ws;
#if MK_LAUNCH_PER_PHASE
    for (int si = -1; si < 24; ++si) { p.ph_lo = si; p.ph_hi = si + 1; hipLaunchKernelGGL(mega, dim3(grid), dim3(512), LDS_BYTES, stream, p); }
#else
    p.ph_lo = -1; p.ph_hi = 24;
    void* args[] = {&p};
    hipError_t e = hipLaunchCooperativeKernel((const void*)mega, dim3(grid), dim3(512), args, LDS_BYTES, stream);
    if (e != hipSuccess) fprintf(stderr, "cooperative launch failed: %s (grid %d)\n", hipGetErrorString(e), grid);
#endif
}
```

```cpp
#include <hip/hip_runtime.h>
#include <hip/hip_cooperative_groups.h>
#include <cstdio>
namespace cg = cooperative_groups;
__device__ __forceinline__ int launder_v(int x) { asm volatile("" : "+v"(x)); return x; }
__device__ __forceinline__ int launder_s(int x) { asm volatile("" : "+s"(x)); return x; }
#define GAS __attribute__((address_space(1)))
typedef const GAS float* gfptr_t;
template <class T> __device__ __forceinline__ T* launder_p(T* p) {
#if defined(__HIP_DEVICE_COMPILE__)
    GAS T* g = (GAS T*)p; asm volatile("" : "+s"(g)); return (T*)g;
#else
    return p;
#endif
}
#define XB_TMO      128
#define XB_XCNT(j)  (256  + 64 * (j))
#define XB_XSUB(j)  (1280 + 64 * (j))
#define XB_XGEN(j)  (2304 + 64 * (j))
#define XB_TOP      3328
#define XB_TOPGEN   3392
#define XCD_BAR_WORDS 3456
#define XB_SPIN_CAP (1u << 18)
#define LAS __attribute__((address_space(3)))

__device__ __forceinline__ unsigned xb_ld(unsigned* p)              { return __hip_atomic_load(p, __ATOMIC_RELAXED, __HIP_MEMORY_SCOPE_AGENT); }
__device__ __forceinline__ unsigned xb_add(unsigned* p, unsigned v) { return __hip_atomic_fetch_add(p, v, __ATOMIC_RELAXED, __HIP_MEMORY_SCOPE_AGENT); }
__device__ __forceinline__ unsigned xb_xcc_id() { return (unsigned)__builtin_amdgcn_s_getreg((3 << 11) | 20) & 0xFu; }
#define XB_SPIN(cond, bar) do { unsigned _sp = 0; while (cond) { __builtin_amdgcn_s_sleep(1); \
    if ((++_sp & 255u) == 0u) { if (xb_ld(&(bar)[XB_TMO])) break; if (_sp > XB_SPIN_CAP) { atomicAdd(&(bar)[XB_TMO], 1u); break; } } } } while (0)

struct XcdBarrier {
    unsigned* bar; unsigned x;
    volatile LAS unsigned* st;
};

__device__ __forceinline__ XcdBarrier xcd_barrier_post(unsigned* bar, volatile LAS unsigned* st) {
    XcdBarrier b; b.bar = bar; b.x = xb_xcc_id(); b.st = st;
    if (threadIdx.x == 0) (void)xb_add(&bar[XB_XCNT(b.x)], 1u);
    return b;
}
__device__ __forceinline__ void xcd_barrier_complete(unsigned* bar, unsigned x, unsigned& nloc, unsigned& nx) {
    const unsigned G = gridDim.x * gridDim.y * gridDim.z;
    unsigned sum, cnt, mine, sp = 0u;
    for (;;) {
        sum = 0u; cnt = 0u; mine = 0u;
#pragma unroll
        for (unsigned j = 0; j < 16; ++j) { const unsigned c = xb_ld(&bar[XB_XCNT(j)]); sum += c; cnt += (c > 0u) ? 1u : 0u; mine = (j == x) ? c : mine; }
        if (sum == G) break;
        __builtin_amdgcn_s_sleep(1);
        if ((++sp & 255u) == 0u) { if (xb_ld(&bar[XB_TMO])) break; if (sp > XB_SPIN_CAP) { atomicAdd(&bar[XB_TMO], 1u); break; } }
    }
    nloc = mine > 0u ? mine : 1u; nx = cnt > 0u ? cnt : 1u;
}

__device__ __forceinline__ void xcd_barrier(const XcdBarrier& b) {
    asm volatile("s_waitcnt vmcnt(0)" ::: "memory");
    __syncthreads();
    if (threadIdx.x == 0) {
        unsigned* bar = b.bar;
        __builtin_amdgcn_s_waitcnt(0);
        unsigned nloc = b.st[0], nx = b.st[1];
        if (nloc == 0u) { xcd_barrier_complete(bar, b.x, nloc, nx); b.st[0] = nloc; b.st[1] = nx; }
        const unsigned old = xb_add(&bar[XB_XSUB(b.x)], 1u);
        const unsigned gen = old / nloc;
        if (old + 1u == (gen + 1u) * nloc) {
            __builtin_amdgcn_fence(__ATOMIC_RELEASE, "agent");
            asm volatile("s_waitcnt vmcnt(0)" ::: "memory");
            const unsigned og = xb_add(&bar[XB_TOP], 1u);
            const unsigned tg = og / nx;
            if (og + 1u == (tg + 1u) * nx) xb_add(&bar[XB_TOPGEN], 1u);
            else XB_SPIN(xb_ld(&bar[XB_TOPGEN]) == tg, bar);
            __builtin_amdgcn_fence(__ATOMIC_ACQUIRE, "agent");
            xb_add(&bar[XB_XGEN(b.x)], 1u);
            asm volatile("s_waitcnt vmcnt(0)" ::: "memory");
        } else {
            XB_SPIN(xb_ld(&bar[XB_XGEN(b.x)]) == gen, bar);
            __builtin_amdgcn_fence(__ATOMIC_ACQUIRE, "agent");
            asm volatile("s_waitcnt vmcnt(0)" ::: "memory");
        }
    }
    __syncthreads();
}
namespace pg8 {
#define PG8_LAS __attribute__((address_space(3)))
typedef unsigned short bf16_t;
typedef short bf16x8 __attribute__((ext_vector_type(8)));
typedef float f32x4 __attribute__((ext_vector_type(4)));
typedef unsigned u32x4 __attribute__((ext_vector_type(4)));
constexpr int BM = 256, BK = 64, HALF = 128, HTB = HALF * BK * 2  , STAGE_BYTES = 8 * HTB, NXCD = 8, WGM = 8;

__host__ __device__ __forceinline__ int lds_byte(int r, int c) { const int st = (r >> 4) * 2 + (c >> 5), rr = r & 15, cc = c & 31, ob = rr * 64 + cc * 2; return st * 1024 + (ob ^ (((ob >> 9) & 1) << 5)); }
__host__ __device__ __forceinline__ void stage_rc(int b, int& R, int& C) { const int st = b / 1024, sb = b % 1024, swz = sb ^ (((sb >> 9) & 1) << 5); R = (st >> 1) * 16 + swz / 64; C = (st & 1) * 32 + (swz % 64) / 2; }
__host__ __device__ __forceinline__ int perm32(int rho) { const int n = rho >> 4, i = rho & 15; return 8 * (i >> 2) + 4 * n + (i & 3); }

struct Unit { int pm, pn; };
struct Gemm { const bf16_t* A; const bf16_t* Bt; int M, N, K; };

struct StaticOrder {
    int nM, nN, nwg, G, c;
    __host__ __device__ void init(int M, int N, int G_, int c_) { nM = M / BM; nN = N / BM; nwg = nM * nN; G = G_; c = c_; }
    __host__ __device__ bool next(int i, Unit& u) const {
        const long L = (long)i * G + c; if (L >= nwg) return false;
        int wgid = (int)L; { const int q = nwg / NXCD, r = nwg % NXCD, xcd = wgid % NXCD, off = wgid / NXCD; wgid = (xcd < r ? xcd * (q + 1) : r * (q + 1) + (xcd - r) * q) + off; }
        const int nig = WGM * nN, gid = wgid / nig, fm = gid * WGM, gsz = (nM - fm) < WGM ? (nM - fm) : WGM;
        u.pm = fm + ((wgid % nig) % gsz); u.pn = (wgid % nig) / gsz; return true;
    }
    __device__ __forceinline__ void a_ready(const Unit&) const {}
    __device__ __forceinline__ void done(const Unit&) const {}
};
__device__ __forceinline__ unsigned cvt_pk_bf16(float lo, float hi) { unsigned r; asm volatile("v_cvt_pk_bf16_f32 %0, %1, %2" : "=v"(r) : "v"(lo), "v"(hi)); return r; }
template <class Epi, class Sched, bool STAMP = false>
__device__ __forceinline__ void gemm_phase(PG8_LAS unsigned char* lds, const Gemm g, const Sched& S, const Epi& E, unsigned long long* stamps) {
    const int tid = launder_v(threadIdx.x), wid = __builtin_amdgcn_readfirstlane(tid >> 6), lane = tid & 63, wr = wid >> 2, wc = wid & 3, fr = lane & 15, fq = lane >> 4;
    const int K = g.K, nt = K / BK;
    int ts_lo = 0, ts_hi = 0, nts = 0; const unsigned long long rt_entry = STAMP ? (unsigned long long)wall_clock64() : 0ull;
#define PG8_STAMP() do { if (STAMP && wid == 0 && nts < 64) { const unsigned long long _c = (unsigned long long)clock64(); \
        ts_lo = (lane == nts) ? (int)(unsigned)_c : ts_lo; ts_hi = (lane == nts) ? (int)(unsigned)(_c >> 32) : ts_hi; ++nts; } } while (0)
    PG8_STAMP();
    unsigned voffA[2], voffB[2];
#pragma unroll
    for (int i = 0; i < 2; ++i) { int R, C; stage_rc(tid * 16 + i * 8192, R, C); const int Rb = Epi::PERM ? ((R & ~31) + perm32(R & 31)) : R;
        voffA[i] = (unsigned)(R * K + C) * 2u; voffB[i] = (unsigned)(Rb * K + C) * 2u; }
    const size_t kstep = (size_t)(BK * 2);
    const size_t hstep = (size_t)HALF * K * 2;
    const size_t tstep = 2 * hstep;
    const unsigned ldsw = (unsigned)wid * 1024u;
    const int aoff = lds_byte(wr * 64 + fr, fq * 8), boff = lds_byte(wc * 32 + fr, fq * 8);
#define PG8_SA(b, h) (((b) * 2 + (h)) * HTB)
#define PG8_SB(b, h) ((4 + (b) * 2 + (h)) * HTB)
#define PG8_STAGE(bufoff, gbase, voff) do { _Pragma("unroll") for (int _i = 0; _i < 2; ++_i) \
        __builtin_amdgcn_global_load_lds((const unsigned*)((const char*)(gbase) + (voff)[_i]), (PG8_LAS unsigned*)(lds + (bufoff) + ldsw + _i * 8192), 16, 0, 0); } while (0)
#define PG8_LDA(dst, b, h) do { _Pragma("unroll") for (int m = 0; m < 4; ++m) _Pragma("unroll") for (int k = 0; k < 2; ++k) dst[m][k] = *(const PG8_LAS bf16x8*)(lds + PG8_SA(b, h) + aoff + m * 2048 + k * 1024); } while (0)
#define PG8_LDB(dst, b, h) do { _Pragma("unroll") for (int n = 0; n < 2; ++n) _Pragma("unroll") for (int k = 0; k < 2; ++k) dst[n][k] = *(const PG8_LAS bf16x8*)(lds + PG8_SB(b, h) + boff + n * 2048 + k * 1024); } while (0)
#define PG8_MMA(ai, bj, At, Bt) do { __builtin_amdgcn_s_setprio(1); _Pragma("unroll") for (int m = 0; m < 4; ++m) _Pragma("unroll") for (int n = 0; n < 2; ++n) _Pragma("unroll") for (int k = 0; k < 2; ++k) \
        acc[ai][bj][m][n] = __builtin_amdgcn_mfma_f32_16x16x32_bf16(Bt[n][k], At[m][k], acc[ai][bj][m][n], 0, 0, 0); __builtin_amdgcn_s_setprio(0); } while (0)
#define PG8_WAIT_V(n) asm volatile("s_waitcnt vmcnt(" #n ")" ::: "memory")
#define PG8_WAIT_L(n) asm volatile("s_waitcnt lgkmcnt(" #n ")" ::: "memory")
#define PG8_BAR __builtin_amdgcn_s_barrier()
#define PG8_SCHED __builtin_amdgcn_sched_barrier(0)
    Unit cur, nxt; int ui = 0;
    if (!S.next(0, cur)) return;
    f32x4 acc[2][2][4][2];
#pragma unroll
    for (int a = 0; a < 2; ++a)
#pragma unroll
        for (int b = 0; b < 2; ++b)
#pragma unroll
            for (int m = 0; m < 4; ++m)
#pragma unroll
                for (int n = 0; n < 2; ++n) acc[a][b][m][n] = (f32x4){0.f, 0.f, 0.f, 0.f};
    bf16x8 At[4][2], B0[2][2], B1[2][2];
    const char* cA = (const char*)g.A + (size_t)cur.pm * tstep; const char* cB = (const char*)g.Bt + (size_t)cur.pn * tstep;
    S.a_ready(cur);
    PG8_STAGE(PG8_SB(0, 0), cB, voffB); PG8_STAGE(PG8_SA(0, 0), cA, voffA); PG8_STAGE(PG8_SB(0, 1), cB + hstep, voffB); PG8_STAGE(PG8_SA(0, 1), cA + hstep, voffA);
    if (wr == 1) PG8_BAR;
    PG8_WAIT_V(4); PG8_BAR;
    PG8_STAGE(PG8_SB(1, 0), cB + kstep, voffB); PG8_STAGE(PG8_SA(1, 0), cA + kstep, voffA); PG8_STAGE(PG8_SB(1, 1), cB + hstep + kstep, voffB);
    PG8_WAIT_V(6); PG8_BAR;
    PG8_STAMP();
    for (;;) {
        const bool has_next = S.next(ui + 1, nxt);
        const char* nA = has_next ? (const char*)g.A + (size_t)nxt.pm * tstep : cA; const char* nB = has_next ? (const char*)g.Bt + (size_t)nxt.pn * tstep : cB;
        for (int t = 0; t < nt; t += 2) {
            const bool last = (t == nt - 2);
            const char* a1 = cA + (size_t)(t + 1) * kstep;
            const char* a2 = last ? nA : cA + (size_t)(t + 2) * kstep; const char* b2 = last ? nB : cB + (size_t)(t + 2) * kstep;
            const char* a3 = a2 + kstep; const char* b3 = b2 + kstep;
            if (last && has_next) S.a_ready(nxt);
            PG8_LDB(B0, 0, 0); PG8_SCHED; PG8_LDA(At, 0, 0); PG8_STAGE(PG8_SA(1, 1), a1 + hstep, voffA);
            PG8_WAIT_L(8); PG8_BAR; PG8_WAIT_L(0); PG8_MMA(0, 0, At, B0); PG8_BAR; PG8_SCHED;
            PG8_LDB(B1, 0, 1); PG8_STAGE(PG8_SB(0, 0), b2, voffB);
            PG8_BAR; PG8_WAIT_L(0); PG8_MMA(0, 1, At, B1); PG8_BAR;
            PG8_LDA(At, 0, 1); PG8_STAGE(PG8_SA(0, 0), a2, voffA);
            PG8_BAR; PG8_WAIT_L(0); PG8_MMA(1, 0, At, B0); PG8_BAR; PG8_SCHED;
            PG8_STAGE(PG8_SB(0, 1), b2 + hstep, voffB);
            PG8_WAIT_V(6); PG8_BAR; PG8_MMA(1, 1, At, B1); PG8_BAR;
            PG8_LDB(B0, 1, 0); PG8_SCHED; PG8_LDA(At, 1, 0); PG8_STAGE(PG8_SA(0, 1), a2 + hstep, voffA);
            PG8_WAIT_L(8); PG8_BAR; PG8_WAIT_L(0); PG8_MMA(0, 0, At, B0); PG8_BAR; PG8_SCHED;
            PG8_LDB(B1, 1, 1); PG8_STAGE(PG8_SB(1, 0), b3, voffB);
            PG8_BAR; PG8_WAIT_L(0); PG8_MMA(0, 1, At, B1); PG8_BAR;
            PG8_LDA(At, 1, 1); PG8_STAGE(PG8_SA(1, 0), a3, voffA);
            PG8_BAR; PG8_WAIT_L(0); PG8_MMA(1, 0, At, B0); PG8_BAR; PG8_SCHED;
            PG8_STAGE(PG8_SB(1, 1), b3 + hstep, voffB);
            PG8_WAIT_V(6); PG8_BAR; PG8_MMA(1, 1, At, B1); PG8_BAR;
        }
        PG8_STAMP();
        if constexpr (!Epi::AFTER_DRAIN) { E(acc, cur, wr, wc, fr, fq); S.done(cur); }
        PG8_STAMP();
        if (!has_next) break;
#pragma unroll
        for (int a = 0; a < 2; ++a)
#pragma unroll
            for (int b = 0; b < 2; ++b)
#pragma unroll
                for (int m = 0; m < 4; ++m)
#pragma unroll
                    for (int n = 0; n < 2; ++n) acc[a][b][m][n] = (f32x4){0.f, 0.f, 0.f, 0.f};
        cur = nxt; cA = nA; cB = nB; ++ui;
    }
    PG8_WAIT_V(0);
    if (wr == 0) PG8_BAR;
    PG8_BAR;
    if constexpr (Epi::AFTER_DRAIN) { E.fused(acc, cur, wr, wc, fr, fq, lds, wid, lane); S.done(cur); }
    PG8_STAMP();
    if (STAMP && wid == 0) { stamps[lane] = lane < nts ? (((unsigned long long)(unsigned)ts_hi << 32) | (unsigned)ts_lo) : 0ull;
        if (lane == 62) stamps[62] = rt_entry; if (lane == 63) stamps[63] = (unsigned long long)wall_clock64(); }
#undef PG8_STAMP
#undef PG8_SA
#undef PG8_SB
#undef PG8_STAGE
#undef PG8_LDA
#undef PG8_LDB
#undef PG8_MMA
#undef PG8_WAIT_V
#undef PG8_WAIT_L
#undef PG8_BAR
#undef PG8_SCHED
}
}

using pg8::bf16_t; using pg8::bf16x8; using pg8::f32x4;
constexpr int MR = 16512, MPAD = 16640;
constexpr int NINP = 4864;
constexpr int C_GLA = 0, C_GMLP = 784, C_RWKV = 1296, C_DIL = 2320;
constexpr float EPS = 1e-6f;

constexpr size_t SZ_WGU1 = (size_t)5632 * 1024 * 2, SZ_WD1 = (size_t)1024 * 2816 * 2, SZ_WIN1 = (size_t)NINP * 1024 * 2, SZ_WOUT1 = (size_t)1024 * 1024 * 2;
constexpr size_t O_WGU = 0;
constexpr size_t O_WD = O_WGU + 4 * SZ_WGU1;
constexpr size_t O_WIN = O_WD + 4 * SZ_WD1;
constexpr size_t O_WOUT = O_WIN + 2 * SZ_WIN1;
constexpr size_t O_XN = O_WOUT + 2 * SZ_WOUT1;
constexpr size_t O_ACT = O_XN + (size_t)MPAD * 1024 * 2;
constexpr size_t O_F = O_ACT + (size_t)MPAD * 2816 * 2;
constexpr size_t O_H = O_F + (size_t)MPAD * 1024 * 4;
constexpr size_t O_COLS = O_H + (size_t)MR * 1024 * 4;
constexpr size_t O_MIX = O_COLS + (size_t)MPAD * NINP * 2;
constexpr size_t O_SSP = O_MIX + (size_t)MPAD * 1024 * 2;
constexpr size_t O_SSPT = O_SSP + (size_t)16384 * 16 * 4;
constexpr size_t O_LSE = O_SSPT + (size_t)128 * 32 * 4;
constexpr size_t O_BON = O_LSE + (size_t)3 * MR * 4 * 4;
constexpr size_t O_CTR = O_BON + (size_t)MR * 4 * 4;
constexpr size_t O_BAR = O_CTR + 256;
constexpr size_t O_LRW = O_BAR + (size_t)3456 * 4 + 256;
constexpr size_t SZ_LRW1 = (size_t)65536 * 2;
constexpr size_t O_GINC = O_LRW + 2 * SZ_LRW1;
constexpr size_t O_GDEC = O_GINC + (size_t)1024 * 2048 * 4;
constexpr size_t WS_END = O_GDEC + (size_t)1024 * 32 * 4;
constexpr size_t SZ_RW = (size_t)MR * 256 * 4;
constexpr size_t O_RR = O_ACT, O_RWD = O_ACT + SZ_RW, O_RK = O_ACT + 2 * SZ_RW, O_RV = O_ACT + 3 * SZ_RW, O_RG = O_ACT + 4 * SZ_RW;
constexpr size_t O_RA = O_F, O_RB = O_F + SZ_RW, O_RY = O_F + 2 * SZ_RW;
constexpr size_t O_DILO = O_XN;
static_assert(5 * SZ_RW <= (size_t)MPAD * 2816 * 2, "rwkv alias");
static_assert(3 * SZ_RW <= (size_t)MPAD * 1024 * 4, "rwkv alias 2");
static_assert((size_t)3 * MR * 256 * 2 <= (size_t)MR * 1024 * 2, "dilo alias");

constexpr size_t OUT_YP = 0;
constexpr size_t OUT_YS = OUT_YP + (size_t)8 * 2048 * 1024;
constexpr size_t OUT_PGLA = OUT_YS + (size_t)32 * 4 * 1024;
constexpr size_t OUT_PRWKV = OUT_PGLA + (size_t)2 * 8 * 4 * 32 * 64;
constexpr size_t OUT_PSHIFT = OUT_PRWKV + (size_t)2 * 8 * 4 * 64 * 64;
constexpr size_t OUT_PW128 = OUT_PSHIFT + (size_t)2 * 8 * 1024;
constexpr size_t OUT_PW512 = OUT_PW128 + (size_t)2 * 8 * 128 * 512;
constexpr size_t OUT_PW2048 = OUT_PW512 + (size_t)2 * 8 * 512 * 512;
constexpr size_t OUT_SGLA = OUT_PW2048 + (size_t)2 * 8 * 2048 * 512;
constexpr size_t OUT_SRWKV = OUT_SGLA + (size_t)2 * 32 * 4 * 32 * 64;
constexpr size_t OUT_SSHIFT = OUT_SRWKV + (size_t)2 * 32 * 4 * 64 * 64;
constexpr size_t OUT_SW128 = OUT_SSHIFT + (size_t)2 * 32 * 1024;
constexpr size_t OUT_SW512 = OUT_SW128 + (size_t)2 * 32 * 4 * 512;
constexpr size_t OUT_SW2048 = OUT_SW512 + (size_t)2 * 32 * 4 * 512;
constexpr size_t OUT_SGV = OUT_SW2048 + (size_t)2 * 32 * 4 * 512;
constexpr size_t OUT_END = OUT_SGV + (size_t)2 * 32 * 4 * 256;

constexpr int LDS_BYTES = 131072;

struct Params { const float* in[32]; float* out; unsigned char* ws; int ph_lo, ph_hi; };
struct Ctx { const gfptr_t* tab; float* out; unsigned char* ws;
    __device__ __forceinline__ const float* in(int i) const { return (const float*)tab[i]; } };

__device__ __forceinline__ float bf2f(bf16_t b) { return __uint_as_float(((unsigned)b) << 16); }
__device__ __forceinline__ bf16_t f2bf(float f) { unsigned u = __float_as_uint(f); u += 0x7FFFu + ((u >> 16) & 1u); return (bf16_t)(u >> 16); }
__device__ __forceinline__ unsigned pack2(float lo, float hi) { return pg8::cvt_pk_bf16(lo, hi); }
__device__ __forceinline__ float wave_sum(float x) {
#pragma unroll
    for (int o = 32; o > 0; o >>= 1) x += __shfl_xor(x, o);
    return x;
}
__device__ __forceinline__ float wave_max(float x) {
#pragma unroll
    for (int o = 32; o > 0; o >>= 1) x = fmaxf(x, __shfl_xor(x, o));
    return x;
}
template <int CTRL> __device__ __forceinline__ float dppf(float x) { return __builtin_bit_cast(float, __builtin_amdgcn_mov_dpp(__builtin_bit_cast(int, x), CTRL, 0xf, 0xf, true)); }
__device__ __forceinline__ float red4_sum(float x) { x += dppf<0xB1>(x); x += dppf<0x4E>(x); return x; }
__device__ __forceinline__ float red8_sum(float x) { x += dppf<0xB1>(x); x += dppf<0x4E>(x); x += dppf<0x141>(x); return x; }
__device__ __forceinline__ float red16_sum(float x) { x += dppf<0xB1>(x); x += dppf<0x4E>(x); x += dppf<0x141>(x); x += dppf<0x128>(x); return x; }
__device__ __forceinline__ float red16_max(float x) { x = fmaxf(x, dppf<0xB1>(x)); x = fmaxf(x, dppf<0x4E>(x)); x = fmaxf(x, dppf<0x141>(x)); x = fmaxf(x, dppf<0x128>(x)); return x; }
__device__ __forceinline__ float sigm(float x) { return __builtin_amdgcn_rcpf(1.f + __expf(-x)); }
__device__ __forceinline__ float gelu_e(float v) {
    const float av = fabsf(v), t = __builtin_amdgcn_rcpf(av * 0.2316418882f + 1.0f);
    float q = t * 0.5307027145f + (-0.7265760135f); q = q * t + 0.7107068705f; q = q * t + (-0.142248368f); q = q * t + 0.127414796f; q = q * t;
    const float e = __builtin_amdgcn_exp2f(v * v * (-0.72134752044f)), m = v * (q * e);
    return v < 0.f ? m : v - m;
}
__device__ __forceinline__ float silu_f(float x) { return x * __builtin_amdgcn_rcpf(1.f + __expf(-x)); }
__device__ __forceinline__ bf16x8 ldfrag(const bf16_t* base, int ld, int row0, int k0, int lane) { return *(const bf16x8*)(base + (row0 + (lane & 15)) * ld + k0 + (lane >> 4) * 8); }
__device__ __forceinline__ f32x4 mma16(bf16x8 a, bf16x8 b, f32x4 c) { return __builtin_amdgcn_mfma_f32_16x16x32_bf16(a, b, c, 0, 0, 0); }

struct EpiSwiGLU {
    static constexpr bool PERM = true, AFTER_DRAIN = false;
    bf16_t* O;
    __device__ __forceinline__ void operator()(const f32x4 (&acc)[2][2][4][2], const pg8::Unit& u, int wr, int wc, int fr, int fq) const {
        const int row0 = u.pm * 256 + wr * 64 + fr, col0 = u.pn * 128 + wc * 32 + 8 * fq;
#pragma unroll
        for (int ai = 0; ai < 2; ++ai)
#pragma unroll
            for (int m = 0; m < 4; ++m) {
                bf16_t* rowp = O + (size_t)(row0 + ai * 128 + m * 16) * 2816 + col0;
                const f32x4 g0 = acc[ai][0][m][0], g1 = acc[ai][0][m][1], u0 = acc[ai][1][m][0], u1 = acc[ai][1][m][1];
                float r[8];
#pragma unroll
                for (int i = 0; i < 4; ++i) { r[i] = silu_f(g0[i]) * u0[i]; r[4 + i] = silu_f(g1[i]) * u1[i]; }
                uint4 w; w.x = pack2(r[0], r[1]); w.y = pack2(r[2], r[3]); w.z = pack2(r[4], r[5]); w.w = pack2(r[6], r[7]);
                *(uint4*)rowp = w;
            }
    }
};
struct EpiBf16P {
    static constexpr bool PERM = true, AFTER_DRAIN = false;
    bf16_t* O; int ldc;
    __device__ __forceinline__ void operator()(const f32x4 (&acc)[2][2][4][2], const pg8::Unit& u, int wr, int wc, int fr, int fq) const {
        const int row0 = u.pm * 256 + wr * 64 + fr, col0 = u.pn * 256 + wc * 32 + 8 * fq;
#pragma unroll
        for (int ai = 0; ai < 2; ++ai)
#pragma unroll
            for (int m = 0; m < 4; ++m) {
                bf16_t* rowp = O + (size_t)(row0 + ai * 128 + m * 16) * ldc + col0;
#pragma unroll
                for (int bj = 0; bj < 2; ++bj) {
                    const f32x4 v0 = acc[ai][bj][m][0], v1 = acc[ai][bj][m][1];
                    uint4 w; w.x = pack2(v0[0], v0[1]); w.y = pack2(v0[2], v0[3]); w.z = pack2(v1[0], v1[1]); w.w = pack2(v1[2], v1[3]);
                    *(uint4*)(rowp + bj * 128) = w;
                }
            }
    }
};
struct EpiBf16SS {
    static constexpr bool PERM = true, AFTER_DRAIN = false;
    bf16_t* C; float* ssp;
    __device__ __forceinline__ void operator()(const f32x4 (&acc)[2][2][4][2], const pg8::Unit& u, int wr, int wc, int fr, int fq) const {
        const int row0 = u.pm * 256 + wr * 64 + fr, col0 = u.pn * 256 + wc * 32 + 8 * fq;
#pragma unroll
        for (int ai = 0; ai < 2; ++ai)
#pragma unroll
            for (int m = 0; m < 4; ++m) {
                const int row = row0 + ai * 128 + m * 16;
                bf16_t* rowp = C + (size_t)row * 1024 + col0;
                float s = 0.f;
#pragma unroll
                for (int bj = 0; bj < 2; ++bj) {
                    const f32x4 v0 = acc[ai][bj][m][0], v1 = acc[ai][bj][m][1];
                    s += (v0[0] * v0[0] + v0[1] * v0[1]) + (v0[2] * v0[2] + v0[3] * v0[3]) + (v1[0] * v1[0] + v1[1] * v1[1]) + (v1[2] * v1[2] + v1[3] * v1[3]);
                    uint4 w; w.x = pack2(v0[0], v0[1]); w.y = pack2(v0[2], v0[3]); w.z = pack2(v1[0], v1[1]); w.w = pack2(v1[2], v1[3]);
                    *(uint4*)(rowp + bj * 128) = w;
                }
                s += __shfl_xor(s, 16); s += __shfl_xor(s, 32);
                if (fq == 0) ssp[(size_t)row * 16 + u.pn * 4 + wc] = s;
            }
    }
};

__device__ __forceinline__ void cvt_tile(const float* __restrict__ src, int ldn, int nvalid, int k0, int n0, bf16_t* __restrict__ dst, int K, int drow0, float* sT) {
    const int tid = threadIdx.x;
    const int nn = tid & 127, n = n0 + nn; const bool ok = n < nvalid;
    const float* sp = src + (size_t)(k0 + (tid >> 7)) * ldn + (ok ? n : 0);
    float v[16];
#pragma unroll
    for (int i = 0; i < 16; ++i) v[i] = sp[(size_t)(i * 4) * ldn];
#pragma unroll
    for (int i = 0; i < 16; ++i) sT[(i * 4 + (tid >> 7)) * 129 + nn] = ok ? v[i] : 0.f;
    __syncthreads();
    const int nl = tid >> 2, kg = tid & 3;
    float x[16];
#pragma unroll
    for (int j = 0; j < 16; ++j) x[j] = sT[(kg * 16 + j) * 129 + nl];
    uint4 w0, w1;
    w0.x = pack2(x[0], x[1]); w0.y = pack2(x[2], x[3]); w0.z = pack2(x[4], x[5]); w0.w = pack2(x[6], x[7]);
    w1.x = pack2(x[8], x[9]); w1.y = pack2(x[10], x[11]); w1.z = pack2(x[12], x[13]); w1.w = pack2(x[14], x[15]);
    uint4* dp = (uint4*)(dst + (size_t)(drow0 + nl) * K + k0 + kg * 16);
    dp[0] = w0; dp[1] = w1;
    __syncthreads();
}
__device__ __forceinline__ void cvt_tile_id(const Ctx& p, int t, float* sT) {
        const float* src; bf16_t* dst; int ldn, nvalid, K, k0, n0, drow0;
        if (t < 4224) {
            const int blk = t / 1056, r = t % 1056, which = r / 352, tt = r % 352;
            if (which < 2) { src = p.in(9 + which) + (size_t)blk * 1024 * 2816; ldn = 2816; nvalid = 2816; K = 1024; k0 = (tt / 22) * 64; n0 = (tt % 22) * 128;
                dst = (bf16_t*)(p.ws + O_WGU + blk * SZ_WGU1); drow0 = (n0 >> 7) * 256 + which * 128; }
            else { src = p.in(11) + (size_t)blk * 2816 * 1024; ldn = 1024; nvalid = 1024; K = 2816; k0 = (tt / 8) * 64; n0 = (tt % 8) * 128;
                dst = (bf16_t*)(p.ws + O_WD + blk * SZ_WD1); drow0 = n0; }
        } else if (t < 5440) {
            const int u = t - 4224, l = u / 608, tt = u % 608;
            src = p.in(12) + (size_t)l * 1024 * 4624; ldn = 4624; nvalid = 4624; K = 1024; k0 = (tt / 38) * 64; n0 = (tt % 38) * 128;
            dst = (bf16_t*)(p.ws + O_WIN + l * SZ_WIN1); drow0 = n0;
        } else if (t >= 5696) {
            const int u = t - 5696, l = u >> 3, tt = u & 7;
            bf16_t* base = (bf16_t*)(p.ws + O_LRW + l * SZ_LRW1);
            ldn = 256; nvalid = 256;
            if (tt < 2) { src = p.in(23) + (size_t)l * 64 * 256; K = 64; k0 = 0; n0 = tt * 128; dst = base; }
            else if (tt < 4) { src = p.in(25) + (size_t)l * 64 * 256; K = 64; k0 = 0; n0 = (tt - 2) * 128; dst = base + 16384; }
            else { src = p.in(26) + (size_t)l * 128 * 256; K = 128; k0 = ((tt - 4) >> 1) * 64; n0 = ((tt - 4) & 1) * 128; dst = base + 32768; }
            drow0 = n0;
        } else {
            const int u = t - 5440, l = u / 128, tt = u % 128;
            src = p.in(13) + (size_t)l * 1024 * 1024; ldn = 1024; nvalid = 1024; K = 1024; k0 = (tt / 8) * 64; n0 = (tt % 8) * 128;
            dst = (bf16_t*)(p.ws + O_WOUT + l * SZ_WOUT1); drow0 = n0;
        }
        cvt_tile(src, ldn, nvalid, k0, n0, dst, K, drow0, sT);
}
__device__ __forceinline__ void phase_prologue(const Ctx& p, unsigned char* smem) {
    const int tid = launder_v(threadIdx.x), bid = blockIdx.x, nb = gridDim.x;
    float* sT = (float*)smem;
    for (int t = bid; t < 5712; t += nb) cvt_tile_id(p, t, sT);
    const int wave = tid >> 6, lane = tid & 63;
    const float* g0 = p.in(8);
    bf16_t* XN = (bf16_t*)(p.ws + O_XN); bf16_t* MIX = (bf16_t*)(p.ws + O_MIX);
    float4 g4[4];
#pragma unroll
    for (int j = 0; j < 4; ++j) g4[j] = *(const float4*)(g0 + j * 256 + lane * 4);
    const int rstep = nb * 8;
    float4 nv[4];
    auto load_x = [&](int r) { const float* x = r < 16384 ? p.in(0) + (size_t)r * 1024 : p.in(1) + (size_t)(r - 16384) * 1024;
#pragma unroll
        for (int j = 0; j < 4; ++j) nv[j] = *(const float4*)(x + j * 256 + lane * 4); };
    int row = bid * 8 + wave;
    if (row < MR) load_x(row);
    for (; row < MPAD; row += rstep) {
        bf16_t* xo = XN + (size_t)row * 1024;
        if (row < MR) {
            float4 v[4]; float ss = 0.f;
#pragma unroll
            for (int j = 0; j < 4; ++j) { v[j] = nv[j]; ss += v[j].x * v[j].x + v[j].y * v[j].y + v[j].z * v[j].z + v[j].w * v[j].w; }
            ss = wave_sum(ss);
            if (row + rstep < MR) load_x(row + rstep);
            const float rs = rsqrtf(ss * (1.f / 1024.f) + EPS);
#pragma unroll
            for (int j = 0; j < 4; ++j) { const float4 g = g4[j];
                uint2 o; o.x = pack2(v[j].x * rs * g.x, v[j].y * rs * g.y); o.y = pack2(v[j].z * rs * g.z, v[j].w * rs * g.w);
                *(uint2*)(xo + j * 256 + lane * 4) = o; }
        } else {
            bf16_t* mo = MIX + (size_t)row * 1024;
#pragma unroll
            for (int j = 0; j < 4; ++j) { *(uint2*)(xo + j * 256 + lane * 4) = make_uint2(0u, 0u); *(uint2*)(mo + j * 256 + lane * 4) = make_uint2(0u, 0u); }
        }
    }
}

__device__ __forceinline__ void phase_ew(const Ctx& p, int l, int kind) {
    const int tid = launder_v(threadIdx.x), wave = tid >> 6, lane = tid & 63;
    const float* ng = p.in(8) + (size_t)l * 6 * 1024;
    const float* gpost = ng + (kind == 0 ? 1 : (kind == 1 ? 3 : 5)) * 1024;
    const float* gpre = kind == 0 ? ng + 2 * 1024 : (kind == 1 ? ng + 4 * 1024 : (l == 0 ? p.in(8) + 6 * 1024 : nullptr));
    const float scale = kind == 1 ? 1.f : 0.5f;
    bf16_t* H = (bf16_t*)(p.ws + O_H); const bf16_t* F = (const bf16_t*)(p.ws + O_F);
    const float* SSP = (const float*)(p.ws + O_SSP); const float* SSPT = (const float*)(p.ws + O_SSPT);
    bf16_t* XN = (bf16_t*)(p.ws + O_XN);
    const bool from_x = (kind == 0 && l == 0), to_out = (kind == 2 && l == 1);
    const float* xin0 = p.in(0); const float* xin1 = p.in(1);
    float4 gp[4], gq[4];
#pragma unroll
    for (int j = 0; j < 4; ++j) { const int c = j * 256 + lane * 4; gp[j] = *(const float4*)(gpost + c); gq[j] = gpre ? *(const float4*)(gpre + c) : make_float4(0.f, 0.f, 0.f, 0.f); }
    const int step = gridDim.x * 8;
    int row = blockIdx.x * 8 + wave;
    float4 fA[4], rA[4], fB[4], rB[4]; float sA = 0.f, sB = 0.f;
    auto load_row = [&](int r, float4 (&fv)[4], float4 (&rv)[4], float& ssl) {
        if (r < 16384) ssl = lane < 16 ? SSP[(size_t)r * 16 + lane] : 0.f; else ssl = lane < 32 ? SSPT[(size_t)(r - 16384) * 32 + lane] : 0.f;
        const float* resx = r < 16384 ? xin0 + (size_t)r * 1024 : xin1 + (size_t)(r - 16384) * 1024;
#pragma unroll
        for (int j = 0; j < 4; ++j) { const int c = j * 256 + lane * 4;
            const uint2 fw = *(const uint2*)(F + (size_t)r * 1024 + c);
            fv[j] = make_float4(__uint_as_float(fw.x << 16), __uint_as_float(fw.x & 0xffff0000u), __uint_as_float(fw.y << 16), __uint_as_float(fw.y & 0xffff0000u));
            if (from_x) rv[j] = *(const float4*)(resx + c);
            else { const uint2 hw = *(const uint2*)(H + (size_t)r * 1024 + c);
                rv[j] = make_float4(__uint_as_float(hw.x << 16), __uint_as_float(hw.x & 0xffff0000u), __uint_as_float(hw.y << 16), __uint_as_float(hw.y & 0xffff0000u)); } }
    };
    auto do_row = [&](int r, float4 (&fv)[4], float4 (&rv)[4], float& ssl) {
        float4 f[4], r4[4];
#pragma unroll
        for (int j = 0; j < 4; ++j) { f[j] = fv[j]; r4[j] = rv[j]; }
        const float ss = wave_sum(ssl);
        if (r + 2 * step < MR) load_row(r + 2 * step, fv, rv, ssl);
        const float rs = rsqrtf(ss * (1.f / 1024.f) + EPS) * scale;
        float4 hv[4]; float s2 = 0.f;
#pragma unroll
        for (int j = 0; j < 4; ++j) {
            float4 h; h.x = r4[j].x + f[j].x * rs * gp[j].x; h.y = r4[j].y + f[j].y * rs * gp[j].y; h.z = r4[j].z + f[j].z * rs * gp[j].z; h.w = r4[j].w + f[j].w * rs * gp[j].w;
            hv[j] = h; s2 += h.x * h.x + h.y * h.y + h.z * h.z + h.w * h.w;
            if (to_out) *(float4*)(p.out + (size_t)r * 1024 + j * 256 + lane * 4) = h;
            else { uint2 o; o.x = pack2(h.x, h.y); o.y = pack2(h.z, h.w); *(uint2*)(H + (size_t)r * 1024 + j * 256 + lane * 4) = o; }
        }
        if (gpre) {
            s2 = wave_sum(s2);
            const float r2 = rsqrtf(s2 * (1.f / 1024.f) + EPS);
#pragma unroll
            for (int j = 0; j < 4; ++j) { const int c = j * 256 + lane * 4;
                uint2 o; o.x = pack2(hv[j].x * r2 * gq[j].x, hv[j].y * r2 * gq[j].y); o.y = pack2(hv[j].z * r2 * gq[j].z, hv[j].w * r2 * gq[j].w);
                *(uint2*)(XN + (size_t)r * 1024 + c) = o; }
        }
    };
    if (row < MR) load_row(row, fA, rA, sA);
    if (row + step < MR) load_row(row + step, fB, rB, sB);
    for (; row < MR; row += 2 * step) {
        do_row(row, fA, rA, sA);
        if (row + step < MR) do_row(row + step, fB, rB, sB);
    }
}

__device__ __forceinline__ void tail_gemm(const bf16_t* __restrict__ A, const bf16_t* __restrict__ Bt, int K, bf16_t* __restrict__ F, float* __restrict__ SSPT, unsigned char* smem) {
    const int tid = launder_v(threadIdx.x), wave = tid >> 6, lane = tid & 63, fr = lane & 15, fq = lane >> 4;
    float* red = (float*)smem;
    for (int item = blockIdx.x; item < 256; item += gridDim.x) {
        const int rg = item >> 5, cgp = item & 31;
        const bf16_t* Ap = A + (size_t)(16384 + rg * 16 + fr) * K + fq * 8;
        const bf16_t* B0 = Bt + (size_t)(cgp * 32 + fr) * K + fq * 8;
        const bf16_t* B1 = B0 + (size_t)16 * K;
        const int kper = K >> 3, kbeg = wave * kper;
        f32x4 acc0 = {0.f, 0.f, 0.f, 0.f}, acc1 = {0.f, 0.f, 0.f, 0.f};
        if (kper == 352) {
            bf16x8 av[11], b0v[11], b1v[11];
#pragma unroll
            for (int i = 0; i < 11; ++i) { av[i] = *(const bf16x8*)(Ap + kbeg + i * 32); b0v[i] = *(const bf16x8*)(B0 + kbeg + i * 32); b1v[i] = *(const bf16x8*)(B1 + kbeg + i * 32); }
#pragma unroll
            for (int i = 0; i < 11; ++i) { acc0 = mma16(av[i], b0v[i], acc0); acc1 = mma16(av[i], b1v[i], acc1); }
        } else {
            bf16x8 av[4], b0v[4], b1v[4];
#pragma unroll
            for (int i = 0; i < 4; ++i) { av[i] = *(const bf16x8*)(Ap + kbeg + i * 32); b0v[i] = *(const bf16x8*)(B0 + kbeg + i * 32); b1v[i] = *(const bf16x8*)(B1 + kbeg + i * 32); }
#pragma unroll
            for (int i = 0; i < 4; ++i) { acc0 = mma16(av[i], b0v[i], acc0); acc1 = mma16(av[i], b1v[i], acc1); }
        }
#pragma unroll
        for (int j = 0; j < 4; ++j) { red[wave * 512 + (fq * 4 + j) * 32 + fr] = acc0[j]; red[wave * 512 + (fq * 4 + j) * 32 + 16 + fr] = acc1[j]; }
        __syncthreads();
        float s = 0.f;
#pragma unroll
        for (int w = 0; w < 8; ++w) s += red[w * 512 + tid];
        const int row = tid >> 5, col = tid & 31;
        F[(size_t)(16384 + rg * 16 + row) * 1024 + cgp * 32 + col] = f2bf(s);
        float q = s * s;
        q += __shfl_xor(q, 1); q += __shfl_xor(q, 2); q += __shfl_xor(q, 4); q += __shfl_xor(q, 8); q += __shfl_xor(q, 16);
        if (col == 0) SSPT[(rg * 16 + row) * 32 + cgp] = q;
        __syncthreads();
    }
}
#ifndef REPMASK
#define REPMASK 0
#endif
#ifndef EXTRA_SYNC
#define EXTRA_SYNC 0
#endif
#ifndef DUP_SMALL
#define DUP_SMALL 0
#endif
#ifndef DUP_RWKV
#define DUP_RWKV 0
#endif
#ifndef TPROBE
#define TPROBE 0
#endif
#ifndef SPLIT_MAIN
#define SPLIT_MAIN 0
#endif
#ifndef DUP_PRE
#define DUP_PRE 0
#endif
#define DUP_PRE_N (DUP_PRE == 1 ? 1032 : (DUP_PRE == 2 ? 1024 : 0))

__device__ __forceinline__ void rwkv_pre_item(const Ctx& p, int l, int item, unsigned char* smem) {
    const int tid = launder_v(threadIdx.x), wave = tid >> 6, lane = tid & 63, fr = lane & 15, fq = lane >> 4;
    constexpr int XRS = 772;
    float* xr = (float*)smem;
    bf16_t* lr = (bf16_t*)(smem + 16 * XRS * 4);
    float* part = (float*)(smem + 16 * XRS * 4 + 16 * 264 * 2);
    const bf16_t* COLS = (const bf16_t*)(p.ws + O_COLS);
    const float* mu = p.in(21) + l * 1024;
    const int r0 = item * 16;
    const bf16_t* LW = (const bf16_t*)(p.ws + O_LRW + l * SZ_LRW1);
    bf16x8 bw[2][2], ba[2][2], bg[2][4];
#pragma unroll
    for (int c2 = 0; c2 < 2; ++c2) { const int ct = wave * 2 + c2;
#pragma unroll
        for (int ks = 0; ks < 2; ++ks) { bw[c2][ks] = *(const bf16x8*)(LW + (ct * 16 + fr) * 64 + ks * 32 + fq * 8); ba[c2][ks] = *(const bf16x8*)(LW + 16384 + (ct * 16 + fr) * 64 + ks * 32 + fq * 8); }
#pragma unroll
        for (int ks = 0; ks < 4; ++ks) bg[c2][ks] = *(const bf16x8*)(LW + 32768 + (ct * 16 + fr) * 128 + ks * 32 + fq * 8); }
    float4 cst[2][5];
#pragma unroll
    for (int c2 = 0; c2 < 2; ++c2) { const int col0 = l * 256 + wave * 32 + c2 * 16 + fq * 4;
        cst[c2][0] = *(const float4*)(p.in(22) + col0); cst[c2][1] = *(const float4*)(p.in(24) + col0); cst[c2][2] = *(const float4*)(p.in(27) + col0); cst[c2][3] = *(const float4*)(p.in(28) + col0); cst[c2][4] = *(const float4*)(p.in(29) + col0); }
    uint4 cwv[4], pwv[4]; uint4 kvw[6];
    const float4 mu0 = *(const float4*)(mu + (tid & 127) * 8), mu1 = *(const float4*)(mu + (tid & 127) * 8 + 4);
#pragma unroll
    for (int i = 0; i < 4; ++i) {
        const int idx = tid + i * 512, tok = idx >> 7, c8 = (idx & 127) * 8, row = r0 + tok;
        cwv[i] = *(const uint4*)(COLS + (size_t)row * NINP + C_RWKV + c8);
        const int t = row < 16384 ? (row & 2047) : ((row - 16384) & 3);
        pwv[i] = make_uint4(0, 0, 0, 0);
        if (t > 0) pwv[i] = *(const uint4*)(COLS + (size_t)(row - 1) * NINP + C_RWKV + c8);
    }
#pragma unroll
    for (int i = 0; i < 6; ++i) { const int idx = tid + i * 512, tok = idx / 192, rem = idx % 192, gi = rem >> 6, cc = (rem & 63) * 8, row = r0 + tok;
        kvw[i] = *(const uint4*)(COLS + (size_t)row * NINP + C_DIL + gi * 768 + 256 + cc); }
#pragma unroll
    for (int i = 0; i < 4; ++i) {
        const int idx = tid + i * 512, tok = idx >> 7, c8 = (idx & 127) * 8, row = r0 + tok;
        float cv[8], pv[8];
        { const unsigned ww[4] = {cwv[i].x, cwv[i].y, cwv[i].z, cwv[i].w};
#pragma unroll
            for (int k = 0; k < 4; ++k) { cv[2 * k] = __uint_as_float(ww[k] << 16); cv[2 * k + 1] = __uint_as_float(ww[k] & 0xffff0000u); } }
        int t, b; bool last; float* shout; bool usestate = false;
        if (row < 16384) { t = row & 2047; b = row >> 11; last = (t == 2047); shout = p.out + OUT_PSHIFT + (size_t)(l * 8 + b) * 1024 + c8; }
        else { const int rr = row - 16384; t = rr & 3; b = rr >> 2; last = (t == 3); shout = p.out + OUT_SSHIFT + (size_t)(l * 32 + b) * 1024 + c8; usestate = (t == 0); }
        if (usestate) { const float4 s0 = *(const float4*)(p.in(7) + (size_t)(l * 32 + b) * 1024 + c8), s1 = *(const float4*)(p.in(7) + (size_t)(l * 32 + b) * 1024 + c8 + 4);
            pv[0] = s0.x; pv[1] = s0.y; pv[2] = s0.z; pv[3] = s0.w; pv[4] = s1.x; pv[5] = s1.y; pv[6] = s1.z; pv[7] = s1.w; }
        else { const unsigned ww[4] = {pwv[i].x, pwv[i].y, pwv[i].z, pwv[i].w};
#pragma unroll
            for (int k = 0; k < 4; ++k) { pv[2 * k] = __uint_as_float(ww[k] << 16); pv[2 * k + 1] = __uint_as_float(ww[k] & 0xffff0000u); } }
        if (last) { *(float4*)shout = make_float4(cv[0], cv[1], cv[2], cv[3]); *(float4*)(shout + 4) = make_float4(cv[4], cv[5], cv[6], cv[7]); }
        const float mm[8] = {mu0.x, mu0.y, mu0.z, mu0.w, mu1.x, mu1.y, mu1.z, mu1.w};
        float xm[8];
#pragma unroll
        for (int k = 0; k < 8; ++k) xm[k] = cv[k] + (pv[k] - cv[k]) * mm[k];
        if (c8 < 768) { *(float4*)(xr + tok * XRS + c8) = make_float4(xm[0], xm[1], xm[2], xm[3]); *(float4*)(xr + tok * XRS + c8 + 4) = make_float4(xm[4], xm[5], xm[6], xm[7]); }
        else {
            if (c8 < 832) {
#pragma unroll
                for (int k = 0; k < 8; ++k) xm[k] = 1.f - 2.f * __builtin_amdgcn_rcpf(1.f + __expf(2.f * xm[k])); }
            else if (c8 >= 896) {
#pragma unroll
                for (int k = 0; k < 8; ++k) xm[k] = sigm(xm[k]); }
            uint4 w; w.x = pack2(xm[0], xm[1]); w.y = pack2(xm[2], xm[3]); w.z = pack2(xm[4], xm[5]); w.w = pack2(xm[6], xm[7]);
            *(uint4*)(lr + tok * 264 + (c8 - 768)) = w;
        }
    }
#pragma unroll
    for (int i = 0; i < 6; ++i) {
        const int idx = tid + i * 512, tok = idx / 192, rem = idx % 192, gi = rem >> 6, cc = (rem & 63) * 8, row = r0 + tok;
        const uint4 cw = kvw[i];
        const float4 f0 = make_float4(__uint_as_float(cw.x << 16), __uint_as_float(cw.x & 0xffff0000u), __uint_as_float(cw.y << 16), __uint_as_float(cw.y & 0xffff0000u));
        const float4 f1 = make_float4(__uint_as_float(cw.z << 16), __uint_as_float(cw.z & 0xffff0000u), __uint_as_float(cw.w << 16), __uint_as_float(cw.w & 0xffff0000u));
        float* dst = nullptr;
        if (row < 16384) {
            const int t = row & 2047, b = row >> 11, W = gi == 0 ? 128 : (gi == 1 ? 512 : 2048);
            const size_t base = gi == 0 ? OUT_PW128 : (gi == 1 ? OUT_PW512 : OUT_PW2048);
            if (t >= 2048 - W) dst = p.out + base + ((size_t)(l * 8 + b) * W + (t - (2048 - W))) * 512 + cc;
        } else {
            const int rr = row - 16384, t = rr & 3, b = rr >> 2;
            const size_t base = gi == 0 ? OUT_SW128 : (gi == 1 ? OUT_SW512 : OUT_SW2048);
            dst = p.out + base + ((size_t)(l * 32 + b) * 4 + t) * 512 + cc;
        }
        if (dst) { *(float4*)dst = f0; *(float4*)(dst + 4) = f1; }
    }
    __syncthreads();
    f32x4 aw[2], aa[2], ag[2];
#pragma unroll
    for (int c2 = 0; c2 < 2; ++c2) {
        aw[c2] = (f32x4){0.f, 0.f, 0.f, 0.f}; aa[c2] = aw[c2]; ag[c2] = aw[c2];
#pragma unroll
        for (int ks = 0; ks < 2; ++ks) {
            aw[c2] = mma16(bw[c2][ks], ldfrag(lr, 264, 0, ks * 32, lane), aw[c2]);
            aa[c2] = mma16(ba[c2][ks], ldfrag(lr, 264, 0, 64 + ks * 32, lane), aa[c2]);
        }
#pragma unroll
        for (int ks = 0; ks < 4; ++ks) ag[c2] = mma16(bg[c2][ks], ldfrag(lr, 264, 0, 128 + ks * 32, lane), ag[c2]);
    }
    float* RR = (float*)(p.ws + O_RR); float* RWD = (float*)(p.ws + O_RWD); float* RK = (float*)(p.ws + O_RK); float* RV = (float*)(p.ws + O_RV);
    float* RG = (float*)(p.ws + O_RG); float* RA = (float*)(p.ws + O_RA); float* RB = (float*)(p.ws + O_RB); float* BON = (float*)(p.ws + O_BON);
    const int tok = fr; const size_t row = (size_t)(r0 + tok);
    float kkv[2][4], av[2][4]; float pk2 = 0.f, pb = 0.f;
#pragma unroll
    for (int c2 = 0; c2 < 2; ++c2) {
        const int col0 = wave * 32 + c2 * 16 + fq * 4;
        const float4 r4 = *(const float4*)(xr + tok * XRS + col0), k4 = *(const float4*)(xr + tok * XRS + 256 + col0), v4 = *(const float4*)(xr + tok * XRS + 512 + col0);
        const float rr[4] = {r4.x, r4.y, r4.z, r4.w}, kx[4] = {k4.x, k4.y, k4.z, k4.w};
        const float w0c[4] = {cst[c2][0].x, cst[c2][0].y, cst[c2][0].z, cst[c2][0].w}, a0c[4] = {cst[c2][1].x, cst[c2][1].y, cst[c2][1].z, cst[c2][1].w};
        const float kkc[4] = {cst[c2][2].x, cst[c2][2].y, cst[c2][2].z, cst[c2][2].w}, kac[4] = {cst[c2][3].x, cst[c2][3].y, cst[c2][3].z, cst[c2][3].w}, rkc[4] = {cst[c2][4].x, cst[c2][4].y, cst[c2][4].z, cst[c2][4].w};
        float dcy[4], kp[4];
#pragma unroll
        for (int j = 0; j < 4; ++j) {
            const float z = -(w0c[j] + aw[c2][j]);
            const float w = -(fmaxf(z, 0.f) + __logf(1.f + __expf(-fabsf(z)))) - 0.5f;
            dcy[j] = __expf(-__expf(w));
            const float a = sigm(a0c[j] + aa[c2][j]);
            const float kk = kx[j] * kkc[j]; kp[j] = kx[j] * (1.f + (a - 1.f) * kac[j]);
            kkv[c2][j] = kk; av[c2][j] = a; pk2 += kk * kk; pb += rr[j] * kp[j] * rkc[j];
        }
        *(float4*)(RR + row * 256 + col0) = r4; *(float4*)(RWD + row * 256 + col0) = make_float4(dcy[0], dcy[1], dcy[2], dcy[3]);
        *(float4*)(RK + row * 256 + col0) = make_float4(kp[0], kp[1], kp[2], kp[3]); *(float4*)(RV + row * 256 + col0) = v4;
        *(float4*)(RG + row * 256 + col0) = make_float4(ag[c2][0], ag[c2][1], ag[c2][2], ag[c2][3]);
    }
    pk2 += __shfl_xor(pk2, 16); pk2 += __shfl_xor(pk2, 32); pb += __shfl_xor(pb, 16); pb += __shfl_xor(pb, 32);
    if (fq == 0) { part[tok * 8 + wave] = pk2; part[128 + tok * 8 + wave] = pb; }
    __syncthreads();
    {
        const float ssq = part[tok * 8 + (wave & 6)] + part[tok * 8 + (wave | 1)];
        const float inv = 1.f / fmaxf(sqrtf(ssq), 1e-12f);
#pragma unroll
        for (int c2 = 0; c2 < 2; ++c2) { const int col0 = wave * 32 + c2 * 16 + fq * 4;
            const float n0 = kkv[c2][0] * inv, n1 = kkv[c2][1] * inv, n2 = kkv[c2][2] * inv, n3 = kkv[c2][3] * inv;
            *(float4*)(RA + row * 256 + col0) = make_float4(-n0, -n1, -n2, -n3);
            *(float4*)(RB + row * 256 + col0) = make_float4(n0 * av[c2][0], n1 * av[c2][1], n2 * av[c2][2], n3 * av[c2][3]); }
        if ((wave & 1) == 0 && fq == 0) BON[row * 4 + (wave >> 1)] = part[128 + tok * 8 + wave] + part[128 + tok * 8 + wave + 1];
    }
    __syncthreads();
}

__device__ __forceinline__ void rwkv_item(const Ctx& p, int l, int sample, int b, int h, int rq, unsigned char* smem) {
    const int tid = launder_v(threadIdx.x), wave = tid >> 6, lane = tid & 63;
    const int T = sample ? 4 : 2048, CT = sample ? 4 : 32, nch = T / CT;
    const size_t rowg0 = sample ? (size_t)(16384 + b * 4) : (size_t)b * 2048;
    float* vec = (float*)smem;
    float* vb = vec + 2 * 5 * 32 * 64;
    float* yb = vb + 2 * 32 * 32;
    const float* arr[5] = {(const float*)(p.ws + O_RA), (const float*)(p.ws + O_RWD), (const float*)(p.ws + O_RK), (const float*)(p.ws + O_RB), (const float*)(p.ws + O_RR)};
    const float* RV = (const float*)(p.ws + O_RV); float* RY = (float*)(p.ws + O_RY);
    const bool loader = wave >= 4;
    const int lt = tid - 256;
    const int kq = lane & 15, rl0 = wave * 4 + (lane >> 4), rl1 = 16 + rl0, vrow0 = rq * 32 + rl0, vrow1 = rq * 32 + rl1;
    typedef float f32x2 __attribute__((ext_vector_type(2)));
    f32x2 A01 = {0.f, 0.f}, A23 = {0.f, 0.f}, B01 = {0.f, 0.f}, B23 = {0.f, 0.f};
    const int NB = sample ? 32 : 8;
    if (!loader && sample) { const float* sp = p.in(6) + (size_t)((l * 32 + b) * 4 + h) * 4096 + kq * 4;
        const float4 s0 = *(const float4*)(sp + vrow0 * 64), s1 = *(const float4*)(sp + vrow1 * 64);
        A01 = (f32x2){s0.x, s0.y}; A23 = (f32x2){s0.z, s0.w}; B01 = (f32x2){s1.x, s1.y}; B23 = (f32x2){s1.z, s1.w}; }
    float4 tA[10]; float4 vA;
    auto issue_chunk = [&](int c, float4 (&tmp)[10], float4& tv) {
        const size_t t0 = rowg0 + (size_t)c * CT;
#pragma unroll
        for (int a = 0; a < 5; ++a)
#pragma unroll
            for (int i = 0; i < 2; ++i) { const int idx = lt + i * 256, r = idx >> 4, c4 = idx & 15; tmp[a * 2 + i] = (r < CT) ? *(const float4*)(arr[a] + (t0 + r) * 256 + h * 64 + c4 * 4) : make_float4(0.f, 0.f, 0.f, 0.f); }
        { const int r = lt >> 3, c4 = lt & 7; tv = (r < CT) ? *(const float4*)(RV + (t0 + r) * 256 + h * 64 + rq * 32 + c4 * 4) : make_float4(0.f, 0.f, 0.f, 0.f); }
    };
    auto commit_chunk = [&](int c, const float4 (&tmp)[10], const float4& tv) {
        const int buf = c & 1;
#pragma unroll
        for (int a = 0; a < 5; ++a)
#pragma unroll
            for (int i = 0; i < 2; ++i) { const int idx = lt + i * 256; *(float4*)(vec + ((size_t)(buf * 5 + a) * 32) * 64 + idx * 4) = tmp[a * 2 + i]; }
        *(float4*)(vb + buf * 1024 + lt * 4) = tv;
    };
    auto flush_y = [&](int c) {
        const int buf = c & 1; const size_t t0 = rowg0 + (size_t)c * CT;
        const int r = lt >> 3, c4 = lt & 7; if (r < CT) *(float4*)(RY + (t0 + r) * 256 + h * 64 + rq * 32 + c4 * 4) = *(const float4*)(yb + buf * 1024 + lt * 4);
    };
    auto compute_chunk = [&](int c) {
        const int buf = c & 1;
        const float4* v4 = (const float4*)(vec + (size_t)buf * 5 * 32 * 64);
        const float* vbb = vb + buf * 1024; float* ybb = yb + buf * 1024;
        float* ydump = yb + 2048 + (tid & 255) * 2;
        const bool kb0 = (kq & 1) != 0, kb1 = (kq & 2) != 0;
        const int ystep = (kq & 1) * 2 + (kq >> 1);
        float* yq0 = (kq < 4) ? (ybb + ystep * 32 + rl0) : ydump;
        float* yq1 = (kq < 4) ? (ybb + ystep * 32 + rl1) : ydump + 1;
        float4 qa[4], qw[4], qk[4], qb[4], qr[4]; float qv0[4], qv1[4];
#pragma unroll
        for (int u = 0; u < 3; ++u) { const int tt = u < CT ? u : CT - 1; qa[u] = v4[(0 * 32 + tt) * 16 + kq]; qw[u] = v4[(1 * 32 + tt) * 16 + kq]; qk[u] = v4[(2 * 32 + tt) * 16 + kq]; qb[u] = v4[(3 * 32 + tt) * 16 + kq]; qr[u] = v4[(4 * 32 + tt) * 16 + kq];
            qv0[u] = vbb[tt * 32 + rl0]; qv1[u] = vbb[tt * 32 + rl1]; }
        __builtin_amdgcn_s_setprio(3);
        for (int t0 = 0; t0 < CT; t0 += 4) {
            float ya[4], yc[4];
#pragma unroll
            for (int u = 0; u < 4; ++u) {
                { const int tn = (t0 + u + 3 < CT) ? t0 + u + 3 : CT - 1; const int sidx = (u + 3) & 3;
                    qa[sidx] = v4[(0 * 32 + tn) * 16 + kq]; qw[sidx] = v4[(1 * 32 + tn) * 16 + kq]; qk[sidx] = v4[(2 * 32 + tn) * 16 + kq]; qb[sidx] = v4[(3 * 32 + tn) * 16 + kq]; qr[sidx] = v4[(4 * 32 + tn) * 16 + kq];
                    qv0[sidx] = vbb[tn * 32 + rl0]; qv1[sidx] = vbb[tn * 32 + rl1]; }
                const f32x2 a01 = {qa[u].x, qa[u].y}, a23 = {qa[u].z, qa[u].w}, w01 = {qw[u].x, qw[u].y}, w23 = {qw[u].z, qw[u].w}, k01 = {qk[u].x, qk[u].y}, k23 = {qk[u].z, qk[u].w};
                const f32x2 b01 = {qb[u].x, qb[u].y}, b23 = {qb[u].z, qb[u].w}, r01 = {qr[u].x, qr[u].y}, r23 = {qr[u].z, qr[u].w};
                const f32x2 v0 = {qv0[u], qv0[u]}, v1 = {qv1[u], qv1[u]};
                const f32x2 tsa = A01 * a01 + A23 * a23, tsb = B01 * a01 + B23 * a23;
                const f32x2 pa01 = A01 * w01 + v0 * k01, pa23 = A23 * w23 + v0 * k23, pb01 = B01 * w01 + v1 * k01, pb23 = B23 * w23 + v1 * k23;
                float sa0 = tsa.x + tsa.y, sa1 = tsb.x + tsb.y;
                sa0 = red16_sum(sa0); sa1 = red16_sum(sa1);
                const f32x2 sv0 = {sa0, sa0}, sv1 = {sa1, sa1};
                A01 = pa01 + sv0 * b01; A23 = pa23 + sv0 * b23; B01 = pb01 + sv1 * b01; B23 = pb23 + sv1 * b23;
                const f32x2 tya = A01 * r01 + A23 * r23, tyb = B01 * r01 + B23 * r23;
                ya[u] = tya.x + tya.y; yc[u] = tyb.x + tyb.y;
            }
            { float u0 = kb0 ? ya[2] : ya[0], u1 = kb0 ? ya[3] : ya[1]; const float s0 = kb0 ? ya[0] : ya[2], s1 = kb0 ? ya[1] : ya[3];
                u0 += dppf<0xB1>(s0); u1 += dppf<0xB1>(s1);
                float vq = kb1 ? u1 : u0; const float sq = kb1 ? u0 : u1;
                vq += dppf<0x4E>(sq); vq += dppf<0x124>(vq); vq += dppf<0x128>(vq);
                yq0[t0 * 32] = vq; }
            { float u0 = kb0 ? yc[2] : yc[0], u1 = kb0 ? yc[3] : yc[1]; const float s0 = kb0 ? yc[0] : yc[2], s1 = kb0 ? yc[1] : yc[3];
                u0 += dppf<0xB1>(s0); u1 += dppf<0xB1>(s1);
                float vq = kb1 ? u1 : u0; const float sq = kb1 ? u0 : u1;
                vq += dppf<0x4E>(sq); vq += dppf<0x124>(vq); vq += dppf<0x128>(vq);
                yq1[t0 * 32] = vq; }
        }
        __builtin_amdgcn_s_setprio(0);
    };
    if (loader) { issue_chunk(0, tA, vA); commit_chunk(0, tA, vA); if (nch > 1) issue_chunk(1, tA, vA); }
    __syncthreads();
    for (int c = 0; c < nch; ++c) {
        if (loader) { if (c + 1 < nch) { commit_chunk(c + 1, tA, vA); if (c + 2 < nch) issue_chunk(c + 2, tA, vA); } if (c > 0) flush_y(c - 1); }
        else compute_chunk(c);
        __syncthreads();
    }
    if (loader) flush_y(nch - 1);
    else { float* so = p.out + (sample ? OUT_SRWKV : OUT_PRWKV) + (size_t)((l * NB + b) * 4 + h) * 4096 + kq * 4;
        *(float4*)(so + vrow0 * 64) = make_float4(A01.x, A01.y, A23.x, A23.y); *(float4*)(so + vrow1 * 64) = make_float4(B01.x, B01.y, B23.x, B23.y); }
    __syncthreads();
}

__device__ __forceinline__ void gla_chunk(const Ctx& p, int l, int mode, int sample, int b, int h, int c, unsigned char* smem) {
    const int tid = launder_v(threadIdx.x), wave = tid >> 6, lane = tid & 63, fr = lane & 15, fq = lane >> 4;
    const int CL = sample ? 4 : 64, nch = sample ? 1 : 32, NB = sample ? 32 : 8;
    const size_t r0 = (sample ? (size_t)(16384 + b * 4) : (size_t)b * 2048) + (size_t)c * CL;
    bf16_t* qe = (bf16_t*)smem;
    bf16_t* ke = qe + 64 * 40;
    bf16_t* kdT = ke + 64 * 40;
    bf16_t* vT = kdT + 32 * 72;
    bf16_t* att = vT + 64 * 72;
    bf16_t* ST = att + 64 * 72;
    float* qf = (float*)(smem + 38400);
    float* kf = qf + 64 * 33;
    float* la = kf + 64 * 33;
    float* bc = la + 64 * 33;
    float* alr = bc + 64 * 33;
    float* w2s = alr + 64 * 17;
    float* bal = w2s + 512;
    float* dec = bal + 32;
    float* Sf = dec + 32;
    float* of = Sf + 2048;
    const bf16_t* COLS = (const bf16_t*)(p.ws + O_COLS);
    bf16_t* MIX = (bf16_t*)(p.ws + O_MIX);
    float* GINC = (float*)(p.ws + O_GINC); float* GDEC = (float*)(p.ws + O_GDEC);
    const int cbase = (b * 4 + h) * 32;
    w2s[tid] = p.in(14)[(size_t)l * 16 * 128 + (tid >> 5) * 128 + h * 32 + (tid & 31)];
    if (tid < 32) bal[tid] = p.in(15)[l * 128 + h * 32 + tid];
    if (mode == 1) {
        float4 S4;
        if (sample) S4 = *(const float4*)(p.in(5) + (size_t)((l * 32 + b) * 4 + h) * 2048 + tid * 4);
        else { S4 = make_float4(0.f, 0.f, 0.f, 0.f); const int kk = tid >> 4;
#pragma unroll 8
            for (int cp = 0; cp < c; ++cp) { const float4 inc = *(const float4*)(GINC + (size_t)(cbase + cp) * 2048 + tid * 4); const float dcy = GDEC[(cbase + cp) * 32 + kk];
                S4.x = dcy * S4.x + inc.x; S4.y = dcy * S4.y + inc.y; S4.z = dcy * S4.z + inc.z; S4.w = dcy * S4.w + inc.w; } }
        *(float4*)(Sf + tid * 4) = S4;
    }
    { uint4 qk = make_uint4(0, 0, 0, 0), vw = qk, al = qk;
        const int tq = (tid & 255) >> 2, pq = tid & 3, isk = tid >> 8, tv = tid >> 3, pvv = tid & 7, ta = tid >> 1, pa = tid & 1;
        if (tq < CL) qk = *(const uint4*)(COLS + (r0 + tq) * NINP + C_GLA + isk * 128 + h * 32 + pq * 8);
        if (tv < CL) vw = *(const uint4*)(COLS + (r0 + tv) * NINP + C_GLA + 256 + h * 64 + pvv * 8);
        if (tid < 128 && ta < CL) al = *(const uint4*)(COLS + (r0 + ta) * NINP + C_GLA + 512 + pa * 8);
        float* qkd = (isk ? kf : qf) + tq * 33 + pq * 8;
        const unsigned w0[4] = {qk.x, qk.y, qk.z, qk.w}, w1[4] = {vw.x, vw.y, vw.z, vw.w}, w2[4] = {al.x, al.y, al.z, al.w};
#pragma unroll
        for (int k = 0; k < 4; ++k) { qkd[2 * k] = __uint_as_float(w0[k] << 16); qkd[2 * k + 1] = __uint_as_float(w0[k] & 0xffff0000u);
            vT[(pvv * 8 + 2 * k) * 72 + tv] = (bf16_t)(w1[k] & 0xffffu); vT[(pvv * 8 + 2 * k + 1) * 72 + tv] = (bf16_t)(w1[k] >> 16); }
        if (tid < 128) {
#pragma unroll
            for (int k = 0; k < 4; ++k) { alr[ta * 17 + pa * 8 + 2 * k] = __uint_as_float(w2[k] << 16); alr[ta * 17 + pa * 8 + 2 * k + 1] = __uint_as_float(w2[k] & 0xffff0000u); } }
    }
    __syncthreads();
    for (int i = tid; i < 2048; i += 512) { const int t = i >> 5, kk = i & 31; float x = bal[kk];
#pragma unroll
        for (int rr = 0; rr < 16; ++rr) x += alr[t * 17 + rr] * w2s[rr * 32 + kk];
        const float ls = fminf(x, 0.f) - __logf(1.f + __expf(-fabsf(x)));
        la[t * 33 + kk] = t < CL ? ls * (1.f / 16.f) : 0.f; }
    __syncthreads();
    { const int kk = tid & 31, tg = tid >> 5;
        float pl[4]; float run = 0.f;
#pragma unroll
        for (int i = 0; i < 4; ++i) { run += la[(tg * 4 + i) * 33 + kk]; pl[i] = run; }
        of[tg * 33 + kk] = run;
        __syncthreads();
        float base = 0.f;
#pragma unroll
        for (int g = 0; g < 16; ++g) { const float x = of[g * 33 + kk]; base += g < tg ? x : 0.f; }
#pragma unroll
        for (int i = 0; i < 4; ++i) bc[(tg * 4 + i) * 33 + kk] = base + pl[i];
    }
    __syncthreads();
    for (int i = tid; i < 2048; i += 512) { const int t = i >> 5, kk = i & 31; const float bb = bc[t * 33 + kk], bl = bc[(CL - 1) * 33 + kk], q = qf[t * 33 + kk], k = kf[t * 33 + kk];
        qe[t * 40 + kk] = f2bf(q * __expf(bb) * 0.17677669529663687f); ke[t * 40 + kk] = f2bf(k * __expf(-bb)); kdT[kk * 72 + t] = t < CL ? f2bf(k * __expf(bl - bb)) : (bf16_t)0; }
    if (tid < 32) dec[tid] = __expf(bc[(CL - 1) * 33 + tid]);
    if (mode == 1) for (int i = tid; i < 2048; i += 512) { const int kk = i >> 6, v = i & 63; ST[v * 40 + kk] = f2bf(Sf[i]); }
    __syncthreads();
    const bool need_inc = (mode == 0) || (c == nch - 1);
    if (mode == 1) {
        for (int ti = wave * 2; ti < wave * 2 + 2; ++ti) {
            const int tt = ti >> 2, st = ti & 3; f32x4 acc = {0.f, 0.f, 0.f, 0.f};
            if (st <= tt) acc = mma16(ldfrag(qe, 40, tt * 16, 0, lane), ldfrag(ke, 40, st * 16, 0, lane), acc);
#pragma unroll
            for (int j = 0; j < 4; ++j) { const int t = tt * 16 + fq * 4 + j, s = st * 16 + fr; att[t * 72 + s] = f2bf(s <= t ? acc[j] : 0.f); }
        }
        __syncthreads();
        for (int ti = wave * 2; ti < wave * 2 + 2; ++ti) {
            const int tt = ti >> 2, vt = ti & 3; f32x4 acc = {0.f, 0.f, 0.f, 0.f};
#pragma unroll
            for (int ks = 0; ks < 2; ++ks) acc = mma16(ldfrag(att, 72, tt * 16, ks * 32, lane), ldfrag(vT, 72, vt * 16, ks * 32, lane), acc);
            acc = mma16(ldfrag(qe, 40, tt * 16, 0, lane), ldfrag(ST, 40, vt * 16, 0, lane), acc);
#pragma unroll
            for (int j = 0; j < 4; ++j) of[(tt * 16 + fq * 4 + j) * 65 + vt * 16 + fr] = acc[j];
        }
    }
    if (need_inc) { const int kt = wave >> 2, vt = wave & 3; f32x4 acc = {0.f, 0.f, 0.f, 0.f};
#pragma unroll
        for (int ks = 0; ks < 2; ++ks) acc = mma16(ldfrag(kdT, 72, kt * 16, ks * 32, lane), ldfrag(vT, 72, vt * 16, ks * 32, lane), acc);
#pragma unroll
        for (int j = 0; j < 4; ++j) { const int kk = kt * 16 + fq * 4 + j, v = vt * 16 + fr;
            if (mode == 0) { GINC[(size_t)(cbase + c) * 2048 + kk * 64 + v] = acc[j]; }
            else { float* so = p.out + (sample ? OUT_SGLA : OUT_PGLA) + (size_t)((l * NB + b) * 4 + h) * 2048; so[kk * 64 + v] = dec[kk] * Sf[kk * 64 + v] + acc[j]; } }
        if (mode == 0 && tid < 32) GDEC[(cbase + c) * 32 + tid] = dec[tid];
    }
    __syncthreads();
    if (mode == 1) { const int t = tid >> 3, part = tid & 7; float ov[8]; float ss = 0.f;
#pragma unroll
        for (int i = 0; i < 8; ++i) { ov[i] = of[t * 65 + part * 8 + i]; ss += ov[i] * ov[i]; }
        ss = red8_sum(ss);
        const float rs = rsqrtf(ss * (1.f / 64.f) + EPS);
        if (t < CL) { const bf16_t* gp = COLS + (r0 + t) * NINP + C_GLA + 528 + h * 64 + part * 8; const float* gn = p.in(16) + l * 256 + h * 64 + part * 8;
            float o[8];
#pragma unroll
            for (int i = 0; i < 8; ++i) o[i] = ov[i] * rs * gn[i] * silu_f(bf2f(gp[i]));
            uint4 w; w.x = pack2(o[0], o[1]); w.y = pack2(o[2], o[3]); w.z = pack2(o[4], o[5]); w.w = pack2(o[6], o[7]);
            *(uint4*)(MIX + (r0 + t) * 1024 + h * 64 + part * 8) = w; }
        __syncthreads();
    }
}

__device__ __forceinline__ void phase_mixer_pre(const Ctx& p0, int l0, unsigned char* smem) {
    for (int item0 = blockIdx.x; item0 < 1032 + 1024 + DUP_PRE_N; item0 += gridDim.x) {
        const Ctx p{p0.tab, launder_p(p0.out), launder_p(p0.ws)}; const int l = launder_s(l0);
        int item = item0;
#if DUP_PRE == 1
        if (item >= 2056) item -= 2056;
#elif DUP_PRE == 2
        if (item >= 2056) item = item - 2056 + 1032;
#endif
        if (item < 1032) rwkv_pre_item(p, l, item, smem);
        else { const int u = item - 1032; gla_chunk(p, l, 0, 0, u >> 7, (u >> 5) & 3, u & 31, smem); }
    }
}

__device__ __forceinline__ void gmlp_prompt_item(const Ctx& p, int l, int id, unsigned char* smem) {
    const int tid = launder_v(threadIdx.x), wave = tid >> 6, lane = tid & 63, fr = lane & 15, fq = lane >> 4;
    const size_t r0 = (size_t)(id >> 4) * 2048 + (size_t)(id & 15) * 128;
    bf16_t* vnT = (bf16_t*)smem;
    bf16_t* Wb = vnT + 256 * 136;
    const bf16_t* COLS = (const bf16_t*)(p.ws + O_COLS);
    bf16_t* MIX = (bf16_t*)(p.ws + O_MIX);
    for (int hf = 0; hf < 4; ++hf) { const int t = hf * 32 + (tid >> 4), part = tid & 15;
        const uint4* src = (const uint4*)(COLS + (r0 + t) * NINP + C_GMLP + 256 + part * 16);
        float x[16]; float s = 0.f;
#pragma unroll
        for (int i = 0; i < 2; ++i) { const uint4 w = src[i]; const unsigned ww[4] = {w.x, w.y, w.z, w.w};
#pragma unroll
            for (int k = 0; k < 4; ++k) { x[i * 8 + k * 2] = gelu_e(__uint_as_float(ww[k] << 16)); x[i * 8 + k * 2 + 1] = gelu_e(__uint_as_float(ww[k] & 0xffff0000u)); } }
#pragma unroll
        for (int i = 0; i < 16; ++i) s += x[i];
        s = red16_sum(s);
        const float mean = s * (1.f / 256.f); float q = 0.f;
#pragma unroll
        for (int i = 0; i < 16; ++i) { const float d = x[i] - mean; q += d * d; }
        q = red16_sum(q);
        const float rstd = rsqrtf(q * (1.f / 256.f) + 1e-5f);
        const float* lg = p.in(17) + l * 256 + part * 16; const float* lb = p.in(18) + l * 256 + part * 16;
#pragma unroll
        for (int i = 0; i < 16; ++i) vnT[(part * 16 + i) * 136 + t] = f2bf((x[i] - mean) * rstd * lg[i] + lb[i]);
    }
    for (int g = 0; g < 4; ++g) {
        const float* W = p.in(19) + (size_t)(l * 4 + g) * 128 * 128;
        const float* bs = p.in(20) + (size_t)(l * 4 + g) * 128;
        const int tt = wave;
        float4 wv[8]; bf16_t uraw[4][4]; float bsv[4];
#pragma unroll
        for (int i = 0; i < 8; ++i) wv[i] = *(const float4*)(W + (size_t)(tid + i * 512) * 4);
#pragma unroll
        for (int j = 0; j < 4; ++j) { const int t = tt * 16 + fq * 4 + j; bsv[j] = bs[t];
#pragma unroll
            for (int ct = 0; ct < 4; ++ct) uraw[j][ct] = COLS[(r0 + t) * NINP + C_GMLP + g * 64 + ct * 16 + fr]; }
#pragma unroll
        for (int i = 0; i < 8; ++i) { const int idx4 = tid + i * 512, t = idx4 >> 5, s4 = (idx4 & 31) * 4;
            uint2 o; o.x = pack2(s4 <= t ? wv[i].x : 0.f, s4 + 1 <= t ? wv[i].y : 0.f); o.y = pack2(s4 + 2 <= t ? wv[i].z : 0.f, s4 + 3 <= t ? wv[i].w : 0.f);
            *(uint2*)(Wb + t * 136 + s4) = o; }
        __syncthreads();
        f32x4 acc[4];
#pragma unroll
        for (int ct = 0; ct < 4; ++ct) acc[ct] = (f32x4){0.f, 0.f, 0.f, 0.f};
#pragma unroll
        for (int ks = 0; ks < 4; ++ks) { const bf16x8 a = ldfrag(Wb, 136, tt * 16, ks * 32, lane);
#pragma unroll
            for (int ct = 0; ct < 4; ++ct) acc[ct] = mma16(a, ldfrag(vnT, 136, g * 64 + ct * 16, ks * 32, lane), acc[ct]); }
#pragma unroll
        for (int j = 0; j < 4; ++j) { const int t = tt * 16 + fq * 4 + j;
#pragma unroll
            for (int ct = 0; ct < 4; ++ct) { const int c = g * 64 + ct * 16 + fr; const float u = gelu_e(bf2f(uraw[j][ct])); MIX[(r0 + t) * 1024 + 256 + c] = f2bf(u * (acc[ct][j] + bsv[j])); } }
        __syncthreads();
    }
}

__device__ __forceinline__ void gmlp_sample_item(const Ctx& p, int l, int b, unsigned char* smem) {
    const int tid = launder_v(threadIdx.x), wave = tid >> 6, lane = tid & 63;
    const size_t r0 = (size_t)(16384 + b * 4);
    float* vv = (float*)smem;
    const bf16_t* COLS = (const bf16_t*)(p.ws + O_COLS);
    bf16_t* MIX = (bf16_t*)(p.ws + O_MIX);
    for (int e = tid; e < 1024; e += 512) { const int t = e >> 8, c = e & 255; vv[e] = gelu_e(bf2f(COLS[(r0 + t) * NINP + C_GMLP + 256 + c])); }
    __syncthreads();
    if (wave < 4) { const int t = wave; float x[4]; float s = 0.f;
#pragma unroll
        for (int i = 0; i < 4; ++i) { x[i] = vv[t * 256 + lane + 64 * i]; s += x[i]; }
        s = wave_sum(s); const float mean = s * (1.f / 256.f); float q = 0.f;
#pragma unroll
        for (int i = 0; i < 4; ++i) { const float d = x[i] - mean; q += d * d; }
        q = wave_sum(q); const float rstd = rsqrtf(q * (1.f / 256.f) + 1e-5f);
#pragma unroll
        for (int i = 0; i < 4; ++i) { const int c = lane + 64 * i; const float vn = (x[i] - mean) * rstd * p.in(17)[l * 256 + c] + p.in(18)[l * 256 + c]; vv[t * 256 + c] = vn;
            p.out[OUT_SGV + ((size_t)(l * 32 + b) * 4 + t) * 256 + c] = vn; } }
    __syncthreads();
    for (int e = tid; e < 1024; e += 512) { const int t = e >> 8, c = e & 255, g = c >> 6;
        const float* W = p.in(19) + (size_t)(l * 4 + g) * 128 * 128 + t * 128;
        float s = p.in(20)[(size_t)(l * 4 + g) * 128 + t];
        for (int s_ = 0; s_ <= t; ++s_) s += W[s_] * vv[s_ * 256 + c];
        const float u = gelu_e(bf2f(COLS[(r0 + t) * NINP + C_GMLP + c]));
        MIX[(r0 + t) * 1024 + 256 + c] = f2bf(u * s); }
    __syncthreads();
}

__device__ __forceinline__ void dil_prompt_item(const Ctx& p, int l, int id, unsigned char* smem) {
    const int tid = launder_v(threadIdx.x), wave = tid >> 6, lane = tid & 63, fr = lane & 15, fq = lane >> 4;
    const int h = id & 3, qb = (id >> 2) & 15, gi = (id >> 6) % 3, b = id / 192;
    const int dsh = gi * 2, d = 1 << dsh, nbk = 16 >> dsh, r = qb / nbk, mb = qb % nbk;
    const bf16_t* cols = (const bf16_t*)(p.ws + O_COLS) + (size_t)(b * 2048) * NINP + C_DIL + gi * 768 + h * 64;
    bf16_t* Ks = (bf16_t*)smem;
    bf16_t* Qs = Ks + 256 * 72;
    bf16_t* Vt = Qs + 128 * 72;
    bf16_t* Pw = (bf16_t*)smem + wave * 16 * 168;
    bf16_t* DILO = (bf16_t*)(p.ws + O_DILO); float* LSE = (float*)(p.ws + O_LSE);
    { const int row = tid >> 1, half = tid & 1, mk = mb * 128 - 128 + row;
        uint4 v0 = make_uint4(0, 0, 0, 0), v1 = v0, v2 = v0, v3 = v0;
        if (mk >= 0) { const uint4* s = (const uint4*)(cols + (size_t)(r + d * mk) * NINP + 256 + half * 32); v0 = s[0]; v1 = s[1]; v2 = s[2]; v3 = s[3]; }
        uint4* dp = (uint4*)(Ks + row * 72 + half * 32); dp[0] = v0; dp[1] = v1; dp[2] = v2; dp[3] = v3; }
    { const int key = tid & 255, dh = tid >> 8, mk = mb * 128 - 128 + key;
        uint4 v[4]; v[0] = make_uint4(0, 0, 0, 0); v[1] = v[0]; v[2] = v[0]; v[3] = v[0];
        if (mk >= 0) { const uint4* s = (const uint4*)(cols + (size_t)(r + d * mk) * NINP + 512 + dh * 32); v[0] = s[0]; v[1] = s[1]; v[2] = s[2]; v[3] = s[3]; }
#pragma unroll
        for (int i = 0; i < 4; ++i) { const unsigned ww[4] = {v[i].x, v[i].y, v[i].z, v[i].w};
#pragma unroll
            for (int k = 0; k < 4; ++k) { Vt[(dh * 32 + i * 8 + k * 2) * 280 + key] = (bf16_t)(ww[k] & 0xffffu); Vt[(dh * 32 + i * 8 + k * 2 + 1) * 280 + key] = (bf16_t)(ww[k] >> 16); } } }
    for (int idx = tid; idx < 64 * 24; idx += 512) Vt[(idx / 24) * 280 + 256 + idx % 24] = 0;
    { const int row = tid >> 2, qt = tid & 3, m = mb * 128 + row;
        const uint4* s = (const uint4*)(cols + (size_t)(r + d * m) * NINP + qt * 16);
        uint4* dp = (uint4*)(Qs + row * 72 + qt * 16); dp[0] = s[0]; dp[1] = s[1]; }
    __syncthreads();
    const int q0 = wave * 16, kx0 = wave * 16;
    f32x4 acc[9];
    { const bf16x8 a0 = ldfrag(Qs, 72, q0, 0, lane), a1 = ldfrag(Qs, 72, q0, 32, lane);
#pragma unroll
        for (int t = 0; t < 9; ++t) { acc[t] = (f32x4){0.f, 0.f, 0.f, 0.f};
            acc[t] = mma16(a0, ldfrag(Ks, 72, kx0 + t * 16, 0, lane), acc[t]); acc[t] = mma16(a1, ldfrag(Ks, 72, kx0 + t * 16, 32, lane), acc[t]); } }
    const float slope = exp2f(-8.f * (float)(gi * 4 + h + 1) / 12.f) * (float)d;
    float mx[4] = {-1e30f, -1e30f, -1e30f, -1e30f}, den[4] = {0.f, 0.f, 0.f, 0.f};
#pragma unroll
    for (int t = 0; t < 9; ++t)
#pragma unroll
        for (int j = 0; j < 4; ++j) { const int qi = q0 + fq * 4 + j, kx = kx0 + t * 16 + fr, dist = qi + 128 - kx;
            const bool valid = dist >= 0 && dist <= 128 && (mb * 128 - 128 + kx) >= 0;
            const float s = valid ? acc[t][j] * 0.125f - slope * (float)dist : -1e30f; acc[t][j] = s; mx[j] = fmaxf(mx[j], s); }
#pragma unroll
    for (int j = 0; j < 4; ++j) mx[j] = red16_max(mx[j]);
#pragma unroll
    for (int t = 0; t < 9; ++t)
#pragma unroll
        for (int j = 0; j < 4; ++j) { const float pv = acc[t][j] > -1e29f ? __expf(acc[t][j] - mx[j]) : 0.f; acc[t][j] = pv; den[j] += pv; }
#pragma unroll
    for (int j = 0; j < 4; ++j) den[j] = red16_sum(den[j]);
    __syncthreads();
#pragma unroll
    for (int t = 0; t < 9; ++t)
#pragma unroll
        for (int j = 0; j < 4; ++j) Pw[(fq * 4 + j) * 168 + t * 16 + fr] = f2bf(acc[t][j]);
    for (int i = lane; i < 16 * 24; i += 64) Pw[(i / 24) * 168 + 144 + i % 24] = 0;
    __syncthreads();
    f32x4 o[4];
#pragma unroll
    for (int dt = 0; dt < 4; ++dt) o[dt] = (f32x4){0.f, 0.f, 0.f, 0.f};
#pragma unroll
    for (int kk = 0; kk < 5; ++kk) { const bf16x8 pa = *(const bf16x8*)(Pw + fr * 168 + kk * 32 + fq * 8);
#pragma unroll
        for (int dt = 0; dt < 4; ++dt) { const bf16x8 vb = *(const bf16x8*)(Vt + (dt * 16 + fr) * 280 + kx0 + kk * 32 + fq * 8); o[dt] = mma16(pa, vb, o[dt]); } }
#pragma unroll
    for (int j = 0; j < 4; ++j) { const int qi = q0 + fq * 4 + j, m = mb * 128 + qi; const size_t rowg = (size_t)b * 2048 + r + d * m; const float inv = 1.f / den[j];
#pragma unroll
        for (int dt = 0; dt < 4; ++dt) DILO[((size_t)gi * MR + rowg) * 256 + h * 64 + dt * 16 + fr] = f2bf(o[dt][j] * inv);
        if (fr == 0) LSE[((size_t)gi * MR + rowg) * 4 + h] = mx[j] + __logf(den[j]); }
    __syncthreads();
}

__device__ __forceinline__ float4 dil_row(const float* cache, const bf16_t* COLS, int l, int b, size_t r0, int gi, int i, int j, int kv, int lane) {
    const int L = gi == 0 ? 128 : (gi == 1 ? 512 : 2048), rel = i - (j << (gi * 2));
    const int relc = rel >= 0 ? rel : 0, rowc = rel < 0 ? L + rel : 0;
    const uint2 w = *(const uint2*)(COLS + (r0 + relc) * NINP + C_DIL + gi * 768 + 256 + kv * 256 + lane * 4);
    const float4 c = *(const float4*)(cache + (((size_t)(l * 32 + b) * L + rowc) * 2 + kv) * 256 + lane * 4);
    const float4 n = make_float4(__uint_as_float(w.x << 16), __uint_as_float(w.x & 0xffff0000u), __uint_as_float(w.y << 16), __uint_as_float(w.y & 0xffff0000u));
    return rel >= 0 ? n : c;
}
__device__ __forceinline__ void dil_sample_item(const Ctx& p, int l, int b, int gi, unsigned char* smem) {
    const int tid = launder_v(threadIdx.x), wave = tid >> 6, lane = tid & 63;
    const size_t r0 = (size_t)(16384 + b * 4);
    float* qs = (float*)smem;
    float* sc = qs + 4 * 256;
    float* mden = sc + 16 * 132;
    float* part = mden + 32;
    const bf16_t* COLS = (const bf16_t*)(p.ws + O_COLS);
    bf16_t* DILO = (bf16_t*)(p.ws + O_DILO); float* LSE = (float*)(p.ws + O_LSE);
    const float* cache = p.in(2 + gi);
    for (int e = tid; e < 1024; e += 512) { const int i = e >> 8, hc = e & 255; qs[e] = bf2f(COLS[(r0 + i) * NINP + C_DIL + gi * 768 + hc]); }
    __syncthreads();
    const int h = lane >> 4;
    const float slope = exp2f(-8.f * (float)(gi * 4 + h + 1) / 12.f);
#pragma unroll 8
    for (int r = wave; r < 516; r += 8) {
        const int i = r / 129, j = r % 129;
        const float4 k4 = dil_row(cache, COLS, l, b, r0, gi, i, j, 0, lane);
        const float4 q4 = *(const float4*)(qs + i * 256 + lane * 4);
        float dot = q4.x * k4.x + q4.y * k4.y + q4.z * k4.z + q4.w * k4.w;
        dot = red16_sum(dot);
        if ((lane & 15) == 0) sc[(i * 4 + h) * 132 + j] = dot * 0.125f - slope * (float)(j << (gi * 2));
    }
    __syncthreads();
    for (int combo = wave; combo < 16; combo += 8) {
        float s0 = sc[combo * 132 + lane], s1 = sc[combo * 132 + 64 + lane], s2 = lane == 0 ? sc[combo * 132 + 128] : -1e30f;
        const float m = wave_max(fmaxf(fmaxf(s0, s1), s2));
        const float p0 = __expf(s0 - m), p1 = __expf(s1 - m), p2 = lane == 0 ? __expf(s2 - m) : 0.f;
        const float dn = wave_sum(p0 + p1 + p2);
        sc[combo * 132 + lane] = p0; sc[combo * 132 + 64 + lane] = p1; if (lane == 0) { sc[combo * 132 + 128] = p2; mden[combo * 2] = m; mden[combo * 2 + 1] = dn; }
    }
    __syncthreads();
    { const int i = wave >> 1, j0 = (wave & 1) * 65, j1 = (wave & 1) ? 129 : 65, combo = i * 4 + h;
        float4 acc = make_float4(0.f, 0.f, 0.f, 0.f);
#pragma unroll 13
        for (int j = j0; j < j1; ++j) { const float4 v4 = dil_row(cache, COLS, l, b, r0, gi, i, j, 1, lane); const float pj = sc[combo * 132 + j];
            acc.x += pj * v4.x; acc.y += pj * v4.y; acc.z += pj * v4.z; acc.w += pj * v4.w; }
        *(float4*)(part + wave * 256 + lane * 4) = acc; }
    __syncthreads();
    for (int e = tid; e < 1024; e += 512) { const int i = e >> 8, c = e & 255, hh = c >> 6, combo = i * 4 + hh;
        const float v = (part[(2 * i) * 256 + c] + part[(2 * i + 1) * 256 + c]) / mden[combo * 2 + 1];
        DILO[((size_t)gi * MR + r0 + i) * 256 + c] = f2bf(v);
        if ((c & 63) == 0) LSE[((size_t)gi * MR + r0 + i) * 4 + hh] = mden[combo * 2] + __logf(mden[combo * 2 + 1]); }
    __syncthreads();
}

__device__ __forceinline__ void phase_mixer_main(const Ctx& p0, int ci, int l0, unsigned char* smem) {
    unsigned* ctr = (unsigned*)(p0.ws + O_CTR) + ci;
    __shared__ int s_item;
    int nxt = 0;
    const bool lead = threadIdx.x == 0;
    if (lead) nxt = (int)atomicAdd(ctr, 1u);
    for (;;) {
        if (lead) s_item = nxt;
        __syncthreads();
        int it = s_item;
        __syncthreads();
        if (lead) nxt = (int)atomicAdd(ctr, 1u);
#if DUP_SMALL == 1
        if (it >= 128 + 2 * 3392) break;
        if (it >= 3520) it -= 3392;
#elif DUP_SMALL == 2
        if (it >= 3520 + 1024) break;
        if (it >= 3520) it = it - 3520 + 160;
#elif DUP_SMALL == 4
        if (it >= 3520 + 800) break;
        if (it >= 3520) it = it - 3520 + 2720;
#elif DUP_SMALL == 5
        if (it >= 3520 + 32) break;
        if (it >= 3520) it = it - 3520 + 128;
#elif DUP_SMALL == 3
        if (it >= 3520 + 1536) break;
        if (it >= 3520) it = it - 3520 + 1184;
#else
        if (it >= 3264) break;
#endif
        const Ctx p{p0.tab, launder_p(p0.out), launder_p(p0.ws)}; const int l = launder_s(l0);
        if (it < 64) rwkv_item(p, l, 0, it >> 3, (it >> 1) & 3, it & 1, smem);
        else if (it < 160) { const int u = it - 64; dil_sample_item(p, l, u / 3, u % 3, smem); }
        else if (it < 1184) { const int u = it - 160; gla_chunk(p, l, 1, 0, u >> 7, (u >> 5) & 3, u & 31, smem); }
        else if (it < 2720) dil_prompt_item(p, l, it - 1184, smem);
        else if (it < 2848) gmlp_prompt_item(p, l, it - 2720, smem);
        else if (it < 3104) { const int u = it - 2848; rwkv_item(p, l, 1, u >> 3, (u >> 1) & 3, u & 1, smem); }
        else if (it < 3232) { const int u = it - 3104; gla_chunk(p, l, 1, 1, u >> 2, u & 3, 0, smem); }
        else gmlp_sample_item(p, l, it - 3232, smem);
    }
}

__device__ __forceinline__ void phase_mixer_post(const Ctx& p, int l) {
    const int tid = launder_v(threadIdx.x), wave = tid >> 6, lane = tid & 63;
    const float* RY = (const float*)(p.ws + O_RY); const float* RV = (const float*)(p.ws + O_RV); const float* RG = (const float*)(p.ws + O_RG); const float* BON = (const float*)(p.ws + O_BON);
    const bf16_t* DILO = (const bf16_t*)(p.ws + O_DILO); const float* LSE = (const float*)(p.ws + O_LSE);
    bf16_t* MIX = (bf16_t*)(p.ws + O_MIX);
    const float* lg = p.in(30) + l * 256; const float* lb = p.in(31) + l * 256;
    float lgv[4], lbv[4];
#pragma unroll
    for (int hh = 0; hh < 4; ++hh) { lgv[hh] = lg[hh * 64 + lane]; lbv[hh] = lb[hh * 64 + lane]; }
    const int step = gridDim.x * 8;
    float ny[4], nbon[4], nrv[4], nrg[4], nls[3][4]; bf16_t ndl[3][4];
    auto load_row = [&](int row) {
#pragma unroll
        for (int hh = 0; hh < 4; ++hh) {
            const int ch = hh * 64 + lane;
            ny[hh] = RY[(size_t)row * 256 + ch]; nbon[hh] = BON[(size_t)row * 4 + hh]; nrv[hh] = RV[(size_t)row * 256 + ch]; nrg[hh] = RG[(size_t)row * 256 + ch];
#pragma unroll
            for (int gi = 0; gi < 3; ++gi) { nls[gi][hh] = LSE[((size_t)gi * MR + row) * 4 + hh]; ndl[gi][hh] = DILO[((size_t)gi * MR + row) * 256 + ch]; }
        }
    };
    int row = blockIdx.x * 8 + wave;
    if (row < MR) load_row(row);
    for (; row < MR; row += step) {
        float y[4], bon[4], rv[4], rg[4], ls[3][4]; bf16_t dl[3][4];
#pragma unroll
        for (int hh = 0; hh < 4; ++hh) { y[hh] = ny[hh]; bon[hh] = nbon[hh]; rv[hh] = nrv[hh]; rg[hh] = nrg[hh];
#pragma unroll
            for (int gi = 0; gi < 3; ++gi) { ls[gi][hh] = nls[gi][hh]; dl[gi][hh] = ndl[gi][hh]; } }
        float mean[4];
#pragma unroll
        for (int hh = 0; hh < 4; ++hh) mean[hh] = wave_sum(y[hh]) * (1.f / 64.f);
        if (row + step < MR) load_row(row + step);
#pragma unroll
        for (int hh = 0; hh < 4; ++hh) {
            const int ch = hh * 64 + lane;
            const float dv = y[hh] - mean[hh];
            const float var = wave_sum(dv * dv) * (1.f / 64.f);
            const float yn = dv * rsqrtf(var + 64e-5f) * lgv[hh] + lbv[hh];
            const float o = (yn + bon[hh] * rv[hh]) * rg[hh];
            MIX[(size_t)row * 1024 + 512 + ch] = f2bf(o);
            const float l0 = ls[0][hh], l1 = ls[1][hh], l2 = ls[2][hh];
            const float mx = fmaxf(l0, fmaxf(l1, l2));
            const float e0 = __expf(l0 - mx), e1 = __expf(l1 - mx), e2 = __expf(l2 - mx), inv = 1.f / (e0 + e1 + e2);
            const float od = (e0 * bf2f(dl[0][hh]) + e1 * bf2f(dl[1][hh]) + e2 * bf2f(dl[2][hh])) * inv;
            MIX[(size_t)row * 1024 + 768 + ch] = f2bf(od);
        }
    }
}

__global__ __launch_bounds__(512, 2) void mega(Params pk) {
    extern __shared__ __attribute__((aligned(16))) unsigned char smem[];
    __shared__ gfptr_t s_in[32];
    __shared__ uint4 xb_words;
    cg::grid_group grid = cg::this_grid();
    if (threadIdx.x == 0) { xb_words = make_uint4(0u, 0u, 0u, 0u);
#pragma unroll
        for (int i = 0; i < 32; ++i) s_in[i] = (gfptr_t)pk.in[i];
    }
    __syncthreads();
    const XcdBarrier xb = xcd_barrier_post((unsigned*)(pk.ws + O_BAR), (volatile LAS unsigned*)&xb_words);
    if (pk.ph_hi == 0x7fffffff) grid.sync();
    for (int si = pk.ph_lo; si < pk.ph_hi; ++si) {
        const int jj = si < 0 ? 12 : si % 12;
        const int reps = (((REPMASK >> jj) & 1) && (jj != 2 || si == 2)) ? 2 : 1;
        for (int rep = 0; rep < reps; ++rep) {
        const Ctx p{s_in, launder_p(pk.out), launder_p(pk.ws)};
#if TPROBE
        const unsigned long long tp0 = __builtin_amdgcn_s_memrealtime();
#endif
        if (si < 0) phase_prologue(p, smem);
        else {
            const int l = si / 12, j = si % 12;
            if (j == 0 || j == 9) {
                const int blk = l * 2 + (j == 9);
                pg8::Gemm g{(const bf16_t*)(p.ws + O_XN), (const bf16_t*)(p.ws + O_WGU + blk * SZ_WGU1), MPAD, 5632, 1024};
                pg8::StaticOrder S; S.init(g.M, g.N, (int)gridDim.x, (int)blockIdx.x);
                EpiSwiGLU E{(bf16_t*)(p.ws + O_ACT)};
                pg8::gemm_phase<EpiSwiGLU, pg8::StaticOrder, false>((PG8_LAS unsigned char*)smem, g, S, E, nullptr);
            } else if (j == 1 || j == 10 || j == 7) {
                const bf16_t* A; const bf16_t* Bt; int K;
                if (j == 7) { A = (const bf16_t*)(p.ws + O_MIX); Bt = (const bf16_t*)(p.ws + O_WOUT + l * SZ_WOUT1); K = 1024; }
                else { A = (const bf16_t*)(p.ws + O_ACT); Bt = (const bf16_t*)(p.ws + O_WD + (l * 2 + (j == 10)) * SZ_WD1); K = 2816; }
                pg8::Gemm g{A, Bt, 16384, 1024, K};
                pg8::StaticOrder S; S.init(g.M, g.N, (int)gridDim.x, (int)blockIdx.x);
                EpiBf16SS E{(bf16_t*)(p.ws + O_F), (float*)(p.ws + O_SSP)};
                pg8::gemm_phase<EpiBf16SS, pg8::StaticOrder, false>((PG8_LAS unsigned char*)smem, g, S, E, nullptr);
                __syncthreads();
                tail_gemm(A, Bt, K, (bf16_t*)(p.ws + O_F), (float*)(p.ws + O_SSPT), smem);
            } else if (j == 2 || j == 8 || j == 11) {
                phase_ew(p, l, j == 2 ? 0 : (j == 8 ? 1 : 2));
            } else if (j == 3) {
                pg8::Gemm g{(const bf16_t*)(p.ws + O_XN), (const bf16_t*)(p.ws + O_WIN + l * SZ_WIN1), MPAD, NINP, 1024};
                pg8::StaticOrder S; S.init(g.M, g.N, (int)gridDim.x, (int)blockIdx.x);
                EpiBf16P E{(bf16_t*)(p.ws + O_COLS), NINP};
                pg8::gemm_phase<EpiBf16P, pg8::StaticOrder, false>((PG8_LAS unsigned char*)smem, g, S, E, nullptr);
            } else if (j == 4) phase_mixer_pre(p, l, smem);
            else if (j == 5) {
#if SPLIT_MAIN
                for (int r5 = 0; r5 < SPLIT_MAIN; ++r5) { if (blockIdx.x < 64) rwkv_item(p, l, 0, blockIdx.x >> 3, (blockIdx.x >> 1) & 3, blockIdx.x & 1, smem); xcd_barrier(xb); }
#endif
                phase_mixer_main(p, l * 2 + rep, l, smem);
            }
            else phase_mixer_post(p, l);
        }
#if TPROBE
        if ((TPROBE >> jj) & 1) { const unsigned long long tp1 = __builtin_amdgcn_s_memrealtime(), tend = tp1 + 4ull * (tp1 - tp0); while (__builtin_amdgcn_s_memrealtime() < tend) __builtin_amdgcn_s_sleep(16); }
#endif
        if (rep + 1 < reps || si + 1 < pk.ph_hi) { xcd_barrier(xb);
#if EXTRA_SYNC
            for (int es = 0; es < EXTRA_SYNC; ++es) xcd_barrier(xb);
#endif
        }
        }
    }
}

#ifndef MK_LAUNCH_PER_PHASE
#define MK_LAUNCH_PER_PHASE 0
#endif
extern "C" void kernel_launch(void* const* d_in, const int* in_sizes, int n_in, void* d_out, int out_size, void* d_ws, size_t ws_size, hipStream_t stream) {
    static int grid = 0;
    if (grid == 0) {
        if (n_in != 32 || (size_t)out_size != OUT_END || ws_size < WS_END) { fprintf(stderr, "kernel_launch: unexpected shapes: n_in %d out %d ws %zu (need %zu)\n", n_in, out_size, ws_size, (size_t)WS_END); grid = -1; return; }
        int dev = 0, cus = 0, per_cu = 0;
        hipGetDevice(&dev); hipDeviceGetAttribute(&cus, hipDeviceAttributeMultiprocessorCount, dev);
        if (hipFuncSetAttribute((const void*)mega, hipFuncAttributeMaxDynamicSharedMemorySize, LDS_BYTES) != hipSuccess) { fprintf(stderr, "kernel_launch: hipFuncSetAttribute failed\n"); grid = -1; return; }
        if (hipOccupancyMaxActiveBlocksPerMultiprocessor(&per_cu, (const void*)mega, 512, LDS_BYTES) != hipSuccess || per_cu < 1) { fprintf(stderr, "kernel_launch: occupancy query says %d\n", per_cu); per_cu = 1; }
        (void)hipGetLastError();
        grid = cus * 1;
    }
    if (grid < 0) return;
    if (hipMemsetAsync((char*)d_ws + O_CTR, 0, 256 + 3456 * 4, stream) != hipSuccess) { fprintf(stderr, "kernel_launch: memset failed\n"); return; }
    Params p{};
    for (int i = 0; i < 32; ++i) p.in[i] = (const float*)d_in[i];
    p.out = (float*)d_out; p.ws = (unsigned char*)d_ws;
#if MK_LAUNCH_PER_PHASE
    for (int si = -1; si < 24; ++si) { p.ph_lo = si; p.ph_hi = si + 1; hipLaunchKernelGGL(mega, dim3(grid), dim3(512), LDS_BYTES, stream, p); }
#else
    p.ph_lo = -1; p.ph_hi = 24;
    void* args[] = {&p};
    hipError_t e = hipLaunchCooperativeKernel((const void*)mega, dim3(grid), dim3(512), args, LDS_BYTES, stream);
    if (e != hipSuccess) fprintf(stderr, "cooperative launch failed: %s (grid %d)\n", hipGetErrorString(e), grid);
#endif
}
```
